# Optimizing an MI355X kernel written in HIP

```python
import jax, jax.numpy as jnp
from jax import lax
import numpy as np

D_MODEL = 1024
BATCH = 16
SEQ = 2048
DEPTH = 2
DEC_BATCH = 32
DEC_SEQ = 32
PAST_LEN = 1024

CHUNK = 64
HEAD_DIM = 64
H_A = 8
KV_A = 2
WINDOW_A = 128
N_PREV_A = WINDOW_A // CHUNK
H_B = 8
N_PREV_B = 8
BAND_B = N_PREV_B * CHUNK
MAX_REL = 128
ROPE_THETA = 10000.0
D_LRU = D_MODEL
N_BLOCKS = 16
BLOCK = D_LRU // N_BLOCKS
CONV_W = 4
C_GATE = 8.0
N_AB = (DEPTH + 1) // 2
N_LRU = DEPTH // 2
EPS = 1e-6
PROJ_SIZES = (H_A * HEAD_DIM, KV_A * HEAD_DIM, KV_A * HEAD_DIM, H_A * HEAD_DIM,
              H_B * HEAD_DIM, H_B * HEAD_DIM, H_B * HEAD_DIM, H_B * HEAD_DIM)
IN_AB = sum(PROJ_SIZES)
MIX_AB = (H_A + H_B) * HEAD_DIM

kernel_name = 'hybrid_stream_swa_band_rglru_step'


def _split_cols(y, sizes):
    offs, acc = [], 0
    for s in sizes[:-1]:
        acc += s
        offs.append(acc)
    return jnp.split(y, offs, axis=-1)


def rms_norm(x, g):
    xf = x.astype(jnp.float32)
    y = xf * lax.rsqrt(jnp.mean(xf * xf, axis=-1, keepdims=True) + EPS)
    return (y * g.astype(jnp.float32)).astype(x.dtype)


def rope(x, pos):
    half = x.shape[-1] // 2
    inv = ROPE_THETA ** (-jnp.arange(half, dtype=jnp.float32) / half)
    ang = pos.astype(jnp.float32)[:, None] * inv[None, :]
    cos = jnp.cos(ang)[None, :, None, :]
    sin = jnp.sin(ang)[None, :, None, :]
    x1 = x[..., :half].astype(jnp.float32)
    x2 = x[..., half:].astype(jnp.float32)
    return jnp.concatenate([x1 * cos - x2 * sin, x2 * cos + x1 * sin], axis=-1).astype(x.dtype)


def attend(q, k, v, q_pos, k_pos, valid, bias_table, sinks):
    _, tq, kvh, g, dh = q.shape
    tk = k.shape[1]
    s = jnp.einsum('bqhgd,bshd->bhgqs', q, k).astype(jnp.float32) * (dh ** -0.5)
    if bias_table is not None:
        rel = jnp.clip(q_pos[:, None] - k_pos[None, :], -MAX_REL, MAX_REL) + MAX_REL
        bias = bias_table.astype(jnp.float32)[:, rel]
        s = s + bias.reshape(kvh, g, tq, tk)
    if valid is not None:
        s = jnp.where(valid, s, -1e30)
    if sinks is not None:
        sink = sinks.astype(jnp.float32).reshape(kvh, g)[None, :, :, None, None]
        m = jnp.maximum(jnp.max(s, axis=-1, keepdims=True), sink)
        p = jnp.exp(s - m)
        p = p / (jnp.sum(p, axis=-1, keepdims=True) + jnp.exp(sink - m))
    else:
        p = jax.nn.softmax(s, axis=-1)
    return jnp.einsum('bhgqs,bshd->bqhgd', p.astype(v.dtype), v)


def prompt_band(q, k, v, n_prev, bias_table, sinks):
    b, s_len, kvh, g, dh = q.shape
    nc = s_len // CHUNK
    pad = n_prev * CHUNK
    span = pad + CHUNK
    kp = jnp.pad(k, ((0, 0), (pad, 0), (0, 0), (0, 0)))
    vp = jnp.pad(v, ((0, 0), (pad, 0), (0, 0), (0, 0)))
    qc = jnp.moveaxis(q.reshape(b, nc, CHUNK, kvh, g, dh), 1, 0)

    def one_chunk(args):
        c, qb = args
        start = c * CHUNK
        kb = lax.dynamic_slice_in_dim(kp, start, span, axis=1)
        vb = lax.dynamic_slice_in_dim(vp, start, span, axis=1)
        q_pos = start + jnp.arange(CHUNK, dtype=jnp.int32)
        k_pos = start - pad + jnp.arange(span, dtype=jnp.int32)
        return attend(qb, kb, vb, q_pos, k_pos, k_pos >= 0, bias_table, sinks)

    out = lax.map(one_chunk, (jnp.arange(nc, dtype=jnp.int32), qc))
    return jnp.moveaxis(out, 0, 1).reshape(b, s_len, kvh, g, dh)


def ab_project(h, pos, w_in):
    b, t, _ = h.shape
    qa, ka, va, ga, qb, kb, vb, gb = _split_cols(h @ w_in, PROJ_SIZES)
    qa = rope(qa.reshape(b, t, H_A, HEAD_DIM), pos).reshape(b, t, KV_A, H_A // KV_A, HEAD_DIM)
    ka = rope(ka.reshape(b, t, KV_A, HEAD_DIM), pos)
    va = va.reshape(b, t, KV_A, HEAD_DIM)
    qb = qb.reshape(b, t, H_B, 1, HEAD_DIM)
    kb = kb.reshape(b, t, H_B, HEAD_DIM)
    vb = vb.reshape(b, t, H_B, HEAD_DIM)
    return qa, ka, va, ga, qb, kb, vb, gb


def ab_output(oa, ob, ga, gb, w_out):
    b, t = oa.shape[0], oa.shape[1]
    y = jnp.concatenate([oa.reshape(b, t, -1) * jax.nn.silu(ga),
                         ob.reshape(b, t, -1) * jax.nn.silu(gb)], axis=-1)
    return y @ w_out


def last_rows(x, n):
    extra = max(0, n - x.shape[1])
    if extra > 0:
        x = jnp.pad(x, ((0, 0), (extra, 0)) + ((0, 0),) * (x.ndim - 2))
    return x[:, x.shape[1] - n:]


def _lin_combine(c1, c2):
    a1, b1 = c1
    a2, b2 = c2
    return a1 * a2, a2 * b1 + b2


def lru_mixer(h, conv_state, h0, w_in, conv_w, conv_b, wa, ba, wx, bx, lam, w_out):
    b, t, _ = h.shape
    xb, z = jnp.split(h @ w_in, 2, axis=-1)
    xp = jnp.concatenate([conv_state.astype(xb.dtype), xb], axis=1)
    xc = conv_b.astype(xb.dtype) + xp[:, 0:t] * conv_w[0]
    for tap in range(1, CONV_W):
        xc = xc + xp[:, tap:tap + t] * conv_w[tap]
    xr = xc.reshape(b, t, N_BLOCKS, BLOCK)
    r = jax.nn.sigmoid(jnp.einsum('btni,nij->btnj', xr, wa).reshape(b, t, D_LRU).astype(jnp.float32)
                       + ba.astype(jnp.float32))
    gi = jax.nn.sigmoid(jnp.einsum('btni,nij->btnj', xr, wx).reshape(b, t, D_LRU).astype(jnp.float32)
                        + bx.astype(jnp.float32))
    log_a = C_GATE * r * jax.nn.log_sigmoid(lam.astype(jnp.float32))
    a = jnp.exp(log_a)
    u = jnp.sqrt(-jnp.expm1(2.0 * log_a)) * (gi * xc.astype(jnp.float32))
    u = u.at[:, 0].add(a[:, 0] * h0.astype(jnp.float32))
    _, hs = lax.associative_scan(_lin_combine, (a, u), axis=1)
    y = hs.astype(h.dtype) * jax.nn.silu(z)
    return y @ w_out, hs[:, -1], xp[:, xp.shape[1] - (CONV_W - 1):]


def setup_inputs(seed: int = 0) -> dict:
    key = jax.random.key(seed)
    ks = jax.random.split(key, 24)
    wa_rows = min(WINDOW_A, PAST_LEN)
    wb_rows = min(BAND_B, PAST_LEN)
    f32 = jnp.float32
    nrm = lambda k, shape, sc: jax.random.normal(k, shape, f32) * sc
    ac = jax.random.uniform(ks[22], (N_LRU, D_LRU), f32, minval=0.9, maxval=0.999)
    a_base = ac ** (1.0 / C_GATE)
    return {
        'x_prompt': nrm(ks[0], (BATCH, SEQ, D_MODEL), 1.0),
        'x_sample': nrm(ks[1], (DEC_BATCH, DEC_SEQ, D_MODEL), 1.0),
        'cache_a_k': nrm(ks[2], (N_AB, DEC_BATCH, wa_rows, KV_A, HEAD_DIM), 1.0),
        'cache_a_v': nrm(ks[3], (N_AB, DEC_BATCH, wa_rows, KV_A, HEAD_DIM), 1.0),
        'cache_b_k': nrm(ks[4], (N_AB, DEC_BATCH, wb_rows, H_B, HEAD_DIM), 1.0),
        'cache_b_v': nrm(ks[5], (N_AB, DEC_BATCH, wb_rows, H_B, HEAD_DIM), 1.0),
        'state_c_h': nrm(ks[6], (N_LRU, DEC_BATCH, D_LRU), 0.5),
        'state_c_conv': nrm(ks[7], (N_LRU, DEC_BATCH, CONV_W - 1, D_LRU), 1.0),
        'ln_pre': 1.0 + nrm(ks[8], (DEPTH, D_MODEL), 0.05),
        'ln_post': 1.0 + nrm(ks[9], (DEPTH, D_MODEL), 0.05),
        'w_in_ab': nrm(ks[10], (N_AB, D_MODEL, IN_AB), D_MODEL ** -0.5),
        'sinks_a': nrm(ks[11], (N_AB, H_A), 0.5),
        'relpos_b': nrm(ks[12], (N_AB, H_B, 2 * MAX_REL + 1), 0.1),
        'w_out_ab': nrm(ks[13], (N_AB, MIX_AB, D_MODEL), MIX_AB ** -0.5),
        'w_in_c': nrm(ks[14], (N_LRU, D_MODEL, 2 * D_LRU), D_MODEL ** -0.5),
        'conv_c_w': nrm(ks[15], (N_LRU, CONV_W, D_LRU), CONV_W ** -0.5),
        'conv_c_b': nrm(ks[16], (N_LRU, D_LRU), 0.01),
        'gate_c_wa': nrm(ks[17], (N_LRU, N_BLOCKS, BLOCK, BLOCK), BLOCK ** -0.5),
        'gate_c_ba': nrm(ks[18], (N_LRU, D_LRU), 0.01),
        'gate_c_wx': nrm(ks[19], (N_LRU, N_BLOCKS, BLOCK, BLOCK), BLOCK ** -0.5),
        'gate_c_bx': nrm(ks[20], (N_LRU, D_LRU), 0.01),
        'lambda_c': jnp.log(a_base) - jnp.log1p(-a_base),
        'w_out_c': nrm(ks[21], (N_LRU, D_LRU, D_MODEL), D_LRU ** -0.5),
    }


def reference(x_prompt, x_sample, cache_a_k, cache_a_v, cache_b_k, cache_b_v, state_c_h, state_c_conv,
              ln_pre, ln_post, w_in_ab, sinks_a, relpos_b, w_out_ab, w_in_c, conv_c_w, conv_c_b,
              gate_c_wa, gate_c_ba, gate_c_wx, gate_c_bx, lambda_c, w_out_c):
    bp, s_len = x_prompt.shape[0], x_prompt.shape[1]
    t = x_sample.shape[1]
    wa_rows = cache_a_k.shape[2]
    wb_rows = cache_b_k.shape[2]
    pos_p = jnp.arange(s_len, dtype=jnp.int32)
    pos_s = PAST_LEN + jnp.arange(t, dtype=jnp.int32)
    kpos_a = PAST_LEN - wa_rows + jnp.arange(wa_rows + t, dtype=jnp.int32)
    kpos_b = PAST_LEN - wb_rows + jnp.arange(wb_rows + t, dtype=jnp.int32)
    nak_p, nav_p, nbk_p, nbv_p, nch_p, ncc_p = [], [], [], [], [], []
    nak_s, nav_s, nbk_s, nbv_s, nch_s, ncc_s = [], [], [], [], [], []
    yp, ys = x_prompt, x_sample
    for l in range(DEPTH):
        j = l // 2
        hp = rms_norm(yp, ln_pre[l])
        hs = rms_norm(ys, ln_pre[l])
        if l % 2 == 0:
            qa, ka, va, ga, qb, kb, vb, gb = ab_project(hp, pos_p, w_in_ab[j])
            oa = prompt_band(qa, ka, va, N_PREV_A, None, sinks_a[j])
            ob = prompt_band(qb, kb, vb, N_PREV_B, relpos_b[j], None)
            mp = ab_output(oa, ob, ga, gb, w_out_ab[j])
            nak_p.append(last_rows(ka, wa_rows))
            nav_p.append(last_rows(va, wa_rows))
            nbk_p.append(last_rows(kb, wb_rows))
            nbv_p.append(last_rows(vb, wb_rows))
            qa, ka, va, ga, qb, kb, vb, gb = ab_project(hs, pos_s, w_in_ab[j])
            ka = jnp.concatenate([cache_a_k[j].astype(ka.dtype), ka], axis=1)
            va = jnp.concatenate([cache_a_v[j].astype(va.dtype), va], axis=1)
            kb = jnp.concatenate([cache_b_k[j].astype(kb.dtype), kb], axis=1)
            vb = jnp.concatenate([cache_b_v[j].astype(vb.dtype), vb], axis=1)
            oa = attend(qa, ka, va, pos_s, kpos_a, None, None, sinks_a[j])
            ob = attend(qb, kb, vb, pos_s, kpos_b, None, relpos_b[j], None)
            ms = ab_output(oa, ob, ga, gb, w_out_ab[j])
            nak_s.append(ka[:, t:])
            nav_s.append(va[:, t:])
            nbk_s.append(kb[:, t:])
            nbv_s.append(vb[:, t:])
        else:
            mp, h_last, conv_last = lru_mixer(
                hp, jnp.zeros((bp, CONV_W - 1, D_LRU), hp.dtype), jnp.zeros((bp, D_LRU), jnp.float32),
                w_in_c[j], conv_c_w[j], conv_c_b[j], gate_c_wa[j], gate_c_ba[j], gate_c_wx[j], gate_c_bx[j],
                lambda_c[j], w_out_c[j])
            nch_p.append(h_last)
            ncc_p.append(conv_last)
            ms, h_last, conv_last = lru_mixer(
                hs, state_c_conv[j], state_c_h[j],
                w_in_c[j], conv_c_w[j], conv_c_b[j], gate_c_wa[j], gate_c_ba[j], gate_c_wx[j], gate_c_bx[j],
                lambda_c[j], w_out_c[j])
            nch_s.append(h_last)
            ncc_s.append(conv_last)
        yp = yp + rms_norm(mp, ln_post[l])
        ys = ys + rms_norm(ms, ln_post[l])
    return (yp, ys,
            jnp.stack(nak_p), jnp.stack(nav_p), jnp.stack(nbk_p), jnp.stack(nbv_p),
            jnp.stack(nch_p), jnp.stack(ncc_p),
            jnp.stack(nak_s), jnp.stack(nav_s), jnp.stack(nbk_s), jnp.stack(nbv_s),
            jnp.stack(nch_s), jnp.stack(ncc_s))
```

```cpp
#include <hip/hip_runtime.h>
#include <cstdio>
#include <cstdint>
namespace pg8 {
#define PG8_LAS __attribute__((address_space(3)))
typedef unsigned short bf16_t;
typedef short bf16x8 __attribute__((ext_vector_type(8)));
typedef float f32x4 __attribute__((ext_vector_type(4)));
typedef unsigned u32x4 __attribute__((ext_vector_type(4)));
constexpr int BM = 256, BK = 64, HALF = 128, HTB = HALF * BK * 2  , STAGE_BYTES = 8 * HTB, NXCD = 8, WGM = 8;

__host__ __device__ __forceinline__ int lds_byte(int r, int c) { const int st = (r >> 4) * 2 + (c >> 5), rr = r & 15, cc = c & 31, ob = rr * 64 + cc * 2; return st * 1024 + (ob ^ (((ob >> 9) & 1) << 5)); }
__host__ __device__ __forceinline__ void stage_rc(int b, int& R, int& C) { const int st = b / 1024, sb = b % 1024, swz = sb ^ (((sb >> 9) & 1) << 5); R = (st >> 1) * 16 + swz / 64; C = (st & 1) * 32 + (swz % 64) / 2; }
__host__ __device__ __forceinline__ int perm32(int rho) { const int n = rho >> 4, i = rho & 15; return 8 * (i >> 2) + 4 * n + (i & 3); }

struct Unit { int pm, pn; };
struct Gemm { const bf16_t* A; const bf16_t* Bt; int M, N, K; };

struct StaticOrder {
    int nM, nN, nwg, G, c;
    __host__ __device__ void init(int M, int N, int G_, int c_) { nM = M / BM; nN = N / BM; nwg = nM * nN; G = G_; c = c_; }
    __host__ __device__ bool next(int i, Unit& u) const {
        const long L = (long)i * G + c; if (L >= nwg) return false;
        int wgid = (int)L; { const int q = nwg / NXCD, r = nwg % NXCD, xcd = wgid % NXCD, off = wgid / NXCD; wgid = (xcd < r ? xcd * (q + 1) : r * (q + 1) + (xcd - r) * q) + off; }
        const int nig = WGM * nN, gid = wgid / nig, fm = gid * WGM, gsz = (nM - fm) < WGM ? (nM - fm) : WGM;
        u.pm = fm + ((wgid % nig) % gsz); u.pn = (wgid % nig) / gsz; return true;
    }
    __device__ __forceinline__ void a_ready(const Unit&) const {}
    __device__ __forceinline__ void done(const Unit&) const {}
};

__device__ __forceinline__ unsigned cvt_pk_bf16(float lo, float hi) { unsigned r; asm volatile("v_cvt_pk_bf16_f32 %0, %1, %2" : "=v"(r) : "v"(lo), "v"(hi)); return r; }
typedef float f32x2 __attribute__((ext_vector_type(2)));

constexpr int EP_MP = 32768, EP_PAST = 1024;
constexpr float EP_C2 = 0.125f * 1.4426950408889634f;
constexpr size_t EO_AKP = 34603008, EO_AVP = 34865152, EO_BKP = 35127296, EO_BVP = 39321600;
constexpr size_t EO_AKS = 43581440, EO_AVS = 44105728, EO_BKS = 44630016, EO_BVS = 53018624;
__device__ __forceinline__ float silu_f(float v) { return v * __builtin_amdgcn_rcpf(1.0f + __builtin_amdgcn_exp2f(-1.4426950408889634f * v)); }
__device__ __forceinline__ f32x4 silu4(f32x4 v) { return (f32x4){silu_f(v[0]), silu_f(v[1]), silu_f(v[2]), silu_f(v[3])}; }
typedef unsigned u32x2 __attribute__((ext_vector_type(2)));
__device__ __forceinline__ u32x2 pack4(f32x4 v) { u32x2 w; w.x = cvt_pk_bf16(v[0], v[1]); w.y = cvt_pk_bf16(v[2], v[3]); return w; }
__device__ __forceinline__ u32x4 pack8(f32x4 a, f32x4 b) { u32x4 w; w.x = cvt_pk_bf16(a[0], a[1]); w.y = cvt_pk_bf16(a[2], a[3]); w.z = cvt_pk_bf16(b[0], b[1]); w.w = cvt_pk_bf16(b[2], b[3]); return w; }

struct EpiF32 {
    static constexpr bool PERM = false, AFTER_DRAIN = false;
    float* C; int ldc;
    __device__ __forceinline__ void operator()(const f32x4 (&acc)[2][2][4][2], const Unit& u, int wr, int wc, int fr, int fq) const {
        const int row0 = u.pm * BM + wr * 64 + fr, col0 = u.pn * BM + wc * 32 + 4 * fq;
#pragma unroll
        for (int ai = 0; ai < 2; ++ai)
#pragma unroll
            for (int m = 0; m < 4; ++m) { float* rowp = C + (size_t)(row0 + ai * HALF + m * 16) * ldc + col0;
#pragma unroll
                for (int bj = 0; bj < 2; ++bj)
#pragma unroll
                    for (int n = 0; n < 2; ++n) *(f32x4*)(rowp + bj * HALF + n * 16) = acc[ai][bj][m][n]; }
    }
};

struct EpiXZ {
    static constexpr bool PERM = true, AFTER_DRAIN = false;
    bf16_t* XB; bf16_t* ZB;
    __device__ __forceinline__ void operator()(const f32x4 (&acc)[2][2][4][2], const Unit& u, int wr, int wc, int fr, int fq) const {
        const int row0 = u.pm * BM + wr * 64 + fr; const bool isz = u.pn >= 4;
        bf16_t* base = isz ? ZB : XB; const int col0 = (u.pn & 3) * BM + wc * 32 + 8 * fq;
#pragma unroll
        for (int ai = 0; ai < 2; ++ai)
#pragma unroll
            for (int m = 0; m < 4; ++m) { bf16_t* rowp = base + (size_t)(row0 + ai * HALF + m * 16) * 1024 + col0;
#pragma unroll
                for (int bj = 0; bj < 2; ++bj) { f32x4 v0 = acc[ai][bj][m][0], v1 = acc[ai][bj][m][1];
                    if (isz) { v0 = silu4(v0); v1 = silu4(v1); }
                    *(u32x4*)(rowp + bj * HALF) = pack8(v0, v1); } }
    }
};

struct EpiQKV {
    static constexpr bool PERM = true, AFTER_DRAIN = false;
    bf16_t *QA, *KA, *VA, *GA, *QB, *KB, *VB, *GB, *KAS, *VAS, *KBS, *VBS;
    const float* rope;
    float* out;
    __device__ __forceinline__ void operator()(const f32x4 (&acc)[2][2][4][2], const Unit& u, int wr, int wc, int fr, int fq) const {
        const int pn = u.pn; const int rowb = u.pm * BM + wr * 64 + fr; const bool sample = u.pm >= EP_MP / BM;
        if (pn <= 2) {
            const int dlow = 16 * (wc & 1) + 4 * fq;
#pragma unroll
            for (int ai = 0; ai < 2; ++ai)
#pragma unroll
                for (int m = 0; m < 4; ++m) {
                    const int row = rowb + ai * HALF + m * 16;
                    const int pos = sample ? (EP_PAST + ((row - EP_MP) & 31)) : (row & 2047);
                    const float* rp = rope + pos * 64 + dlow;
                    const f32x4 cs = *(const f32x4*)rp, sn = *(const f32x4*)(rp + 32);
                    float* fA = nullptr; long boffA;
                    if (sample) { const int rs = row - EP_MP, b = rs >> 5, t = rs & 31; fA = out + (size_t)(b * 128 + 96 + t) * 128; boffA = (long)(b * 160 + 128 + t) * 128; }
                    else { const int b = row >> 11, t = row & 2047; if (t >= 1920) fA = out + (size_t)(b * 128 + (t - 1920)) * 128; boffA = (long)row * 128; }
#pragma unroll
                    for (int bj = 0; bj < 2; ++bj) {
                        const f32x4 x1 = acc[ai][bj][m][0], x2 = acc[ai][bj][m][1];
                        if (pn < 2) {
                            const f32x4 o1 = (x1 * cs - x2 * sn) * EP_C2, o2 = (x2 * cs + x1 * sn) * EP_C2;
                            bf16_t* d = QA + (size_t)row * 512 + (4 * pn + 2 * bj + (wc >> 1)) * 64 + dlow;
                            *(u32x2*)d = pack4(o1); *(u32x2*)(d + 32) = pack4(o2);
                        } else if (bj == 0) {
                            const f32x4 o1 = x1 * cs - x2 * sn, o2 = x2 * cs + x1 * sn; const int c = (wc >> 1) * 64 + dlow;
                            bf16_t* d = (sample ? KAS : KA) + boffA + c;
                            *(u32x2*)d = pack4(o1); *(u32x2*)(d + 32) = pack4(o2);
                            if (fA) { float* f = fA + (sample ? EO_AKS : EO_AKP) + c; *(f32x4*)f = o1; *(f32x4*)(f + 32) = o2; }
                        } else {
                            const int c = wc * 32 + 8 * fq;
                            bf16_t* d = (sample ? VAS : VA) + boffA + c; *(u32x4*)d = pack8(x1, x2);
                            if (fA) { float* f = fA + (sample ? EO_AVS : EO_AVP) + c; *(f32x4*)f = x1; *(f32x4*)(f + 4) = x2; }
                        }
                    }
                }
        } else {
            const int kind = (pn - 3) >> 1;
            const int colt = ((pn - 3) & 1) * BM + wc * 32 + 8 * fq;
            bf16_t* base = kind == 0 ? GA : kind == 1 ? QB : kind == 2 ? KB : kind == 3 ? VB : GB;
            const bool iskv = (kind == 2 || kind == 3);
            bf16_t* sbase = kind == 2 ? KBS : VBS;
            const size_t fo_p = kind == 2 ? EO_BKP : EO_BVP, fo_s = kind == 2 ? EO_BKS : EO_BVS;
#pragma unroll
            for (int ai = 0; ai < 2; ++ai)
#pragma unroll
                for (int m = 0; m < 4; ++m) {
                    const int row = rowb + ai * HALF + m * 16;
                    bf16_t* bd = base + (size_t)row * 512 + colt; float* fd = nullptr;
                    if (iskv) {
                        if (sample) { const int rs = row - EP_MP, b = rs >> 5, t = rs & 31; fd = out + fo_s + (size_t)(b * 512 + 480 + t) * 512 + colt; bd = sbase + (size_t)(b * 544 + 512 + t) * 512 + colt; }
                        else { const int b = row >> 11, t = row & 2047; if (t >= 1536) fd = out + fo_p + (size_t)(b * 512 + (t - 1536)) * 512 + colt; }
                    }
#pragma unroll
                    for (int bj = 0; bj < 2; ++bj) {
                        f32x4 v0 = acc[ai][bj][m][0], v1 = acc[ai][bj][m][1];
                        if (kind == 0 || kind == 4) { v0 = silu4(v0); v1 = silu4(v1); }
                        if (kind == 1) { v0 = v0 * EP_C2; v1 = v1 * EP_C2; }
                        *(u32x4*)(bd + bj * HALF) = pack8(v0, v1);
                        if (fd) { *(f32x4*)(fd + bj * HALF) = v0; *(f32x4*)(fd + bj * HALF + 4) = v1; }
                    }
                }
        }
    }
};
template <class Epi, class Sched, bool ALIGN_EPI = false, bool SP2 = false>
__device__ __forceinline__ void gemm_phase(PG8_LAS unsigned char* lds, const Gemm g, const Sched& S, const Epi& E) {
    const int tid = threadIdx.x, wid = __builtin_amdgcn_readfirstlane(tid >> 6), lane = tid & 63, wr = wid >> 2, wc = wid & 3, fr = lane & 15, fq = lane >> 4;
    const int K = g.K, nt = K / BK;
    unsigned voffA[2], voffB[2];
#pragma unroll
    for (int i = 0; i < 2; ++i) { int R, C; stage_rc(tid * 16 + i * 8192, R, C); const int Rb = Epi::PERM ? ((R & ~31) + perm32(R & 31)) : R;
        voffA[i] = (unsigned)(R * K + C) * 2u; voffB[i] = (unsigned)(Rb * K + C) * 2u; }
    const size_t kstep = (size_t)(BK * 2);
    const size_t hstep = (size_t)HALF * K * 2;
    const size_t tstep = 2 * hstep;
    const unsigned ldsw = (unsigned)wid * 1024u;
    const int aoff = lds_byte(wr * 64 + fr, fq * 8), boff = lds_byte(wc * 32 + fr, fq * 8);
#define PG8_SA(b, h) (((b) * 2 + (h)) * HTB)
#define PG8_SB(b, h) ((4 + (b) * 2 + (h)) * HTB)
#define PG8_STAGE(bufoff, gbase, voff) do { _Pragma("unroll") for (int _i = 0; _i < 2; ++_i) \
        __builtin_amdgcn_global_load_lds((const unsigned*)((const char*)(gbase) + (voff)[_i]), (PG8_LAS unsigned*)(lds + (bufoff) + ldsw + _i * 8192), 16, 0, 0); } while (0)
#define PG8_LDA(dst, b, h) do { _Pragma("unroll") for (int m = 0; m < 4; ++m) _Pragma("unroll") for (int k = 0; k < 2; ++k) dst[m][k] = *(const PG8_LAS bf16x8*)(lds + PG8_SA(b, h) + aoff + m * 2048 + k * 1024); } while (0)
#define PG8_LDB(dst, b, h) do { _Pragma("unroll") for (int n = 0; n < 2; ++n) _Pragma("unroll") for (int k = 0; k < 2; ++k) dst[n][k] = *(const PG8_LAS bf16x8*)(lds + PG8_SB(b, h) + boff + n * 2048 + k * 1024); } while (0)
#define PG8_MMA(ai, bj, At, Bt) do { __builtin_amdgcn_s_setprio(1); _Pragma("unroll") for (int m = 0; m < 4; ++m) _Pragma("unroll") for (int n = 0; n < 2; ++n) _Pragma("unroll") for (int k = 0; k < 2; ++k) \
        acc[ai][bj][m][n] = __builtin_amdgcn_mfma_f32_16x16x32_bf16(Bt[n][k], At[m][k], acc[ai][bj][m][n], 0, 0, 0); __builtin_amdgcn_s_setprio(0); } while (0)
#define PG8_WAIT_V(n) asm volatile("s_waitcnt vmcnt(" #n ")" ::: "memory")
#define PG8_WAIT_L(n) asm volatile("s_waitcnt lgkmcnt(" #n ")" ::: "memory")
#define PG8_BAR __builtin_amdgcn_s_barrier()
#define PG8_SCHED __builtin_amdgcn_sched_barrier(0)
    Unit cur, nxt; int ui = 0;
    if (!S.next(0, cur)) return;
    f32x4 acc[2][2][4][2];
#pragma unroll
    for (int a = 0; a < 2; ++a)
#pragma unroll
        for (int b = 0; b < 2; ++b)
#pragma unroll
            for (int m = 0; m < 4; ++m)
#pragma unroll
                for (int n = 0; n < 2; ++n) acc[a][b][m][n] = (f32x4){0.f, 0.f, 0.f, 0.f};
    bf16x8 At[4][2], B0[2][2], B1[2][2];
    const char* cA = (const char*)g.A + (size_t)cur.pm * tstep; const char* cB = (const char*)g.Bt + (size_t)cur.pn * tstep;
    S.a_ready(cur);
    if constexpr (SP2) {
        PG8_STAGE(PG8_SB(0, 0), cB, voffB); PG8_STAGE(PG8_SB(0, 1), cB + hstep, voffB); PG8_STAGE(PG8_SA(0, 0), cA, voffA); PG8_STAGE(PG8_SA(0, 1), cA + hstep, voffA);
        if (wr == 1) PG8_BAR;
        PG8_WAIT_V(2); PG8_BAR;
        PG8_STAGE(PG8_SB(1, 0), cB + kstep, voffB); PG8_STAGE(PG8_SA(1, 0), cA + kstep, voffA); PG8_STAGE(PG8_SB(1, 1), cB + hstep + kstep, voffB);
        PG8_WAIT_V(6); PG8_BAR;
    } else {
        PG8_STAGE(PG8_SB(0, 0), cB, voffB); PG8_STAGE(PG8_SA(0, 0), cA, voffA); PG8_STAGE(PG8_SB(0, 1), cB + hstep, voffB); PG8_STAGE(PG8_SA(0, 1), cA + hstep, voffA);
        if (wr == 1) PG8_BAR;
        PG8_WAIT_V(4); PG8_BAR;
        PG8_STAGE(PG8_SB(1, 0), cB + kstep, voffB); PG8_STAGE(PG8_SA(1, 0), cA + kstep, voffA); PG8_STAGE(PG8_SB(1, 1), cB + hstep + kstep, voffB);
        PG8_WAIT_V(6); PG8_BAR;
    }
    for (;;) {
        const bool has_next = S.next(ui + 1, nxt);
        const char* nA = has_next ? (const char*)g.A + (size_t)nxt.pm * tstep : cA; const char* nB = has_next ? (const char*)g.Bt + (size_t)nxt.pn * tstep : cB;
        for (int t = 0; t < nt; t += 2) {
            const bool last = (t == nt - 2);
            const char* a1 = cA + (size_t)(t + 1) * kstep;
            const char* a2 = last ? nA : cA + (size_t)(t + 2) * kstep; const char* b2 = last ? nB : cB + (size_t)(t + 2) * kstep;
            const char* a3 = a2 + kstep; const char* b3 = b2 + kstep;
            if (last && has_next) S.a_ready(nxt);
            if constexpr (SP2) {
            PG8_LDB(B0, 0, 0); PG8_LDB(B1, 0, 1); PG8_SCHED; PG8_LDA(At, 0, 0); PG8_STAGE(PG8_SA(1, 1), a1 + hstep, voffA);
            PG8_WAIT_V(8); PG8_WAIT_L(0); PG8_BAR; PG8_MMA(0, 0, At, B0); PG8_MMA(0, 1, At, B1); PG8_BAR; PG8_SCHED;
            PG8_LDA(At, 0, 1); PG8_STAGE(PG8_SB(0, 0), b2, voffB); PG8_STAGE(PG8_SB(0, 1), b2 + hstep, voffB); PG8_STAGE(PG8_SA(0, 0), a2, voffA);
            PG8_WAIT_V(8); PG8_WAIT_L(0); PG8_BAR; PG8_MMA(1, 0, At, B0); PG8_MMA(1, 1, At, B1); PG8_BAR; PG8_SCHED;
            PG8_LDB(B0, 1, 0); PG8_LDB(B1, 1, 1); PG8_SCHED; PG8_LDA(At, 1, 0); PG8_STAGE(PG8_SA(0, 1), a2 + hstep, voffA);
            PG8_WAIT_V(8); PG8_WAIT_L(0); PG8_BAR; PG8_MMA(0, 0, At, B0); PG8_MMA(0, 1, At, B1); PG8_BAR; PG8_SCHED;
            PG8_LDA(At, 1, 1); PG8_STAGE(PG8_SB(1, 0), b3, voffB); PG8_STAGE(PG8_SB(1, 1), b3 + hstep, voffB); PG8_STAGE(PG8_SA(1, 0), a3, voffA);
            PG8_WAIT_V(8); PG8_WAIT_L(0); PG8_BAR; PG8_MMA(1, 0, At, B0); PG8_MMA(1, 1, At, B1); PG8_BAR; PG8_SCHED;
            } else {
            PG8_LDB(B0, 0, 0); PG8_SCHED; PG8_LDA(At, 0, 0); PG8_STAGE(PG8_SA(1, 1), a1 + hstep, voffA);
            PG8_WAIT_L(8); PG8_BAR; PG8_WAIT_L(0); PG8_MMA(0, 0, At, B0); PG8_BAR; PG8_SCHED;
            PG8_LDB(B1, 0, 1); PG8_STAGE(PG8_SB(0, 0), b2, voffB);
            PG8_BAR; PG8_WAIT_L(0); PG8_MMA(0, 1, At, B1); PG8_BAR;
            PG8_LDA(At, 0, 1); PG8_STAGE(PG8_SA(0, 0), a2, voffA);
            PG8_BAR; PG8_WAIT_L(0); PG8_MMA(1, 0, At, B0); PG8_BAR; PG8_SCHED;
            PG8_STAGE(PG8_SB(0, 1), b2 + hstep, voffB);
            PG8_WAIT_V(6); PG8_BAR; PG8_MMA(1, 1, At, B1); PG8_BAR;
            PG8_LDB(B0, 1, 0); PG8_SCHED; PG8_LDA(At, 1, 0); PG8_STAGE(PG8_SA(0, 1), a2 + hstep, voffA);
            PG8_WAIT_L(8); PG8_BAR; PG8_WAIT_L(0); PG8_MMA(0, 0, At, B0); PG8_BAR; PG8_SCHED;
            PG8_LDB(B1, 1, 1); PG8_STAGE(PG8_SB(1, 0), b3, voffB);
            PG8_BAR; PG8_WAIT_L(0); PG8_MMA(0, 1, At, B1); PG8_BAR;
            PG8_LDA(At, 1, 1); PG8_STAGE(PG8_SA(1, 0), a3, voffA);
            PG8_BAR; PG8_WAIT_L(0); PG8_MMA(1, 0, At, B0); PG8_BAR; PG8_SCHED;
            PG8_STAGE(PG8_SB(1, 1), b3 + hstep, voffB);
            PG8_WAIT_V(6); PG8_BAR; PG8_MMA(1, 1, At, B1); PG8_BAR;
            }
        }
        if constexpr (ALIGN_EPI) { if (wr == 0) PG8_BAR; }
        if constexpr (!Epi::AFTER_DRAIN) { E(acc, cur, wr, wc, fr, fq); S.done(cur); }
        if (!has_next) break;
#pragma unroll
        for (int a = 0; a < 2; ++a)
#pragma unroll
            for (int b = 0; b < 2; ++b)
#pragma unroll
                for (int m = 0; m < 4; ++m)
#pragma unroll
                    for (int n = 0; n < 2; ++n) acc[a][b][m][n] = (f32x4){0.f, 0.f, 0.f, 0.f};
        cur = nxt; cA = nA; cB = nB; ++ui;
        if constexpr (ALIGN_EPI) { if (wr == 1) PG8_BAR; }
    }
    PG8_WAIT_V(0);
    if constexpr (!ALIGN_EPI) { if (wr == 0) PG8_BAR; }
    PG8_BAR;
    if constexpr (Epi::AFTER_DRAIN) { E.fused(acc, cur, wr, wc, fr, fq, lds, wid, lane); S.done(cur); }
#undef PG8_SA
#undef PG8_SB
#undef PG8_STAGE
#undef PG8_LDA
#undef PG8_LDB
#undef PG8_MMA
#undef PG8_WAIT_V
#undef PG8_WAIT_L
#undef PG8_BAR
#undef PG8_SCHED
}
}
#define GAS __attribute__((address_space(1)))
#define LAS __attribute__((address_space(3)))
typedef unsigned short bf16;
typedef unsigned v4u __attribute__((ext_vector_type(4)));
typedef float f32x4 __attribute__((ext_vector_type(4)));
typedef short bf16x8 __attribute__((ext_vector_type(8)));
typedef GAS unsigned gu32;
typedef GAS unsigned long long gu64;
#define RLX_AGENT __ATOMIC_RELAXED, __HIP_MEMORY_SCOPE_AGENT
#define LDS_WAIT() asm volatile("s_waitcnt lgkmcnt(0)" ::: "memory")
#define VM_WAIT() asm volatile("s_waitcnt vmcnt(0)" ::: "memory")
__device__ __forceinline__ unsigned long long rt() { return __builtin_amdgcn_s_memrealtime(); }
__device__ __forceinline__ unsigned f2bf(float f) { unsigned u = __builtin_bit_cast(unsigned, f); return (u + 0x7fffu + ((u >> 16) & 1u)) >> 16; }
__device__ __forceinline__ unsigned pk2(float lo, float hi) { return f2bf(lo) | (f2bf(hi) << 16); }

#define XB_TMO      128
#define XB_XCNT(j)  (256  + 64 * (j))
#define XB_XSUB(j)  (1280 + 64 * (j))
#define XB_XGEN(j)  (2304 + 64 * (j))
#define XB_TOP      3328
#define XB_TOPGEN   3392
#define XCD_BAR_WORDS 3456
#define XB_SPIN_CAP (1u << 18)

__device__ __forceinline__ unsigned xb_ld(unsigned* p)              { return __hip_atomic_load(p, __ATOMIC_RELAXED, __HIP_MEMORY_SCOPE_AGENT); }
__device__ __forceinline__ unsigned xb_add(unsigned* p, unsigned v) { return __hip_atomic_fetch_add(p, v, __ATOMIC_RELAXED, __HIP_MEMORY_SCOPE_AGENT); }
__device__ __forceinline__ unsigned xb_xcc_id() { return (unsigned)__builtin_amdgcn_s_getreg((3 << 11) | 20) & 0xFu; }
#define XB_SPIN(cond, bar) do { unsigned _sp = 0; while (cond) { __builtin_amdgcn_s_sleep(1); \
    if ((++_sp & 255u) == 0u) { if (xb_ld(&(bar)[XB_TMO])) break; if (_sp > XB_SPIN_CAP) { atomicAdd(&(bar)[XB_TMO], 1u); break; } } } } while (0)

struct XcdBarrier {
    unsigned* bar; unsigned x;
    volatile LAS unsigned* st;
};

__device__ __forceinline__ XcdBarrier xcd_barrier_post(unsigned* bar, volatile LAS unsigned* st) {
    XcdBarrier b; b.bar = bar; b.x = xb_xcc_id(); b.st = st;
    if (threadIdx.x == 0) (void)xb_add(&bar[XB_XCNT(b.x)], 1u);
    return b;
}
__device__ __forceinline__ void xcd_barrier_complete(unsigned* bar, unsigned x, unsigned& nloc, unsigned& nx) {
    const unsigned G = gridDim.x * gridDim.y * gridDim.z;
    unsigned sum, cnt, mine, sp = 0u;
    for (;;) {
        sum = 0u; cnt = 0u; mine = 0u;
#pragma unroll
        for (unsigned j = 0; j < 16; ++j) { const unsigned c = xb_ld(&bar[XB_XCNT(j)]); sum += c; cnt += (c > 0u) ? 1u : 0u; mine = (j == x) ? c : mine; }
        if (sum == G) break;
        __builtin_amdgcn_s_sleep(1);
        if ((++sp & 255u) == 0u) { if (xb_ld(&bar[XB_TMO])) break; if (sp > XB_SPIN_CAP) { atomicAdd(&bar[XB_TMO], 1u); break; } }
    }
    nloc = mine > 0u ? mine : 1u; nx = cnt > 0u ? cnt : 1u;
}

__device__ __forceinline__ void xcd_barrier(const XcdBarrier& b) {
    asm volatile("s_waitcnt vmcnt(0)" ::: "memory");
    __syncthreads();
    if (threadIdx.x == 0) {
        unsigned* bar = b.bar;
        __builtin_amdgcn_s_waitcnt(0);
        unsigned nloc = b.st[0], nx = b.st[1];
        if (nloc == 0u) { xcd_barrier_complete(bar, b.x, nloc, nx); b.st[0] = nloc; b.st[1] = nx; }
        const unsigned old = xb_add(&bar[XB_XSUB(b.x)], 1u);
        const unsigned gen = old / nloc;
        if (old + 1u == (gen + 1u) * nloc) {
            __builtin_amdgcn_fence(__ATOMIC_RELEASE, "agent");
            asm volatile("s_waitcnt vmcnt(0)" ::: "memory");
            const unsigned og = xb_add(&bar[XB_TOP], 1u);
            const unsigned tg = og / nx;
            if (og + 1u == (tg + 1u) * nx) xb_add(&bar[XB_TOPGEN], 1u);
            else XB_SPIN(xb_ld(&bar[XB_TOPGEN]) == tg, bar);
            __builtin_amdgcn_fence(__ATOMIC_ACQUIRE, "agent");
            xb_add(&bar[XB_XGEN(b.x)], 1u);
            asm volatile("s_waitcnt vmcnt(0)" ::: "memory");
        } else {
            XB_SPIN(xb_ld(&bar[XB_XGEN(b.x)]) == gen, bar);
            __builtin_amdgcn_fence(__ATOMIC_ACQUIRE, "agent");
            asm volatile("s_waitcnt vmcnt(0)" ::: "memory");
        }
    }
    __syncthreads();
}

constexpr int NWAVES = 8;
constexpr int DM = 1024, BATCH = 16, SEQ = 2048, DEC_B = 32, DEC_T = 32, PAST = 1024;
constexpr int MP = BATCH * SEQ, MS = DEC_B * DEC_T, M = MP + MS;
constexpr int NIN = 3328;
constexpr float EPS = 1e-6f, LOG2E = 1.4426950408889634f;
constexpr size_t O_Y = 0, O_AKP = 34603008, O_AVP = 34865152, O_BKP = 35127296, O_BVP = 39321600, O_CHP = 43515904, O_CCP = 43532288,
                 O_AKS = 43581440, O_AVS = 44105728, O_BKS = 44630016, O_BVS = 53018624, O_CHS = 61407232, O_CCS = 61440000, O_END = 61538304;
static_assert(O_AKP == (size_t)M * DM && O_AKP == pg8::EO_AKP && O_AVP == pg8::EO_AVP && O_BKP == pg8::EO_BKP && O_BVP == pg8::EO_BVP && O_AKS == pg8::EO_AKS && O_AVS == pg8::EO_AVS && O_BKS == pg8::EO_BKS && O_BVS == pg8::EO_BVS, "d_out map");

constexpr size_t MiB = 1u << 20;
constexpr size_t WS_CTL = 0, CTL_ZERO_BYTES = 1 * MiB;
constexpr size_t WS_WIN0 = 1 * MiB;
constexpr size_t WS_WOUT0 = 8 * MiB;
constexpr size_t WS_WIN1 = 10 * MiB;
constexpr size_t WS_WOUT1 = 14 * MiB;
constexpr size_t WS_ROPE = 16 * MiB;
constexpr size_t WS_XN = 17 * MiB;
constexpr size_t WS_MIX = 84 * MiB;
constexpr size_t WS_R1 = 151 * MiB;
constexpr size_t SZ512 = (size_t)M * 512 * 2, SZ128 = (size_t)M * 128 * 2;
constexpr size_t R_QA = 0, R_GA = R_QA + SZ512, R_QB = R_GA + SZ512, R_KB = R_QB + SZ512, R_VB = R_KB + SZ512, R_GB = R_VB + SZ512, R_KA = R_GB + SZ512, R_VA = R_KA + SZ128,
                 R_KAS = R_VA + SZ128, R_VAS = R_KAS + (size_t)32 * 160 * 128 * 2, R_KBS = R_VAS + (size_t)32 * 160 * 128 * 2, R_VBS = R_KBS + (size_t)32 * 544 * 512 * 2, R_END = R_VBS + (size_t)32 * 544 * 512 * 2;
static_assert(R_END <= 256 * MiB, "R1 region");
constexpr size_t R_M1 = 0;
constexpr size_t R_XB = 0, R_ZB = (size_t)M * 1024 * 2;
constexpr size_t WS_END = WS_R1 + 256 * MiB;
constexpr int CW_BAR = 4096;

constexpr int RING_OFF = 0, RING_BYTES = 131072;
constexpr int LDSCTL_OFF = RING_BYTES, MISC_OFF = LDSCTL_OFF + 320;
constexpr int LDS_BYTES = 147456;
static_assert(MISC_OFF + 128 <= LDS_BYTES, "LDS map");

struct Args { const float* in[23]; float* out; unsigned char* ws; int ph_lo, ph_hi; };
static_assert(sizeof(Args) == 23 * 8 + 8 + 8 + 8, "Args has no padding");
struct Frame {
    LAS unsigned char* lds;
    volatile LAS unsigned* MISC;
    gu32* ctl;
    int tid, lane, wave;
    int vcu, G;
};
typedef const __attribute__((address_space(4))) Args* CArgs;
__device__ __forceinline__ CArgs kargs() { auto p = __builtin_amdgcn_kernarg_segment_ptr(); asm volatile("" : "+s"(p)); return (CArgs)p; }
#define A_IN(k) (A->in[k])
#define A_XP A_IN(0)
#define A_XS A_IN(1)
#define A_CAK A_IN(2)
#define A_CAV A_IN(3)
#define A_CBK A_IN(4)
#define A_CBV A_IN(5)
#define A_STH A_IN(6)
#define A_STCONV A_IN(7)
#define A_LNPRE A_IN(8)
#define A_LNPOST A_IN(9)
#define A_WIN0 A_IN(10)
#define A_SINKS A_IN(11)
#define A_RELPOS A_IN(12)
#define A_WOUT0 A_IN(13)
#define A_WIN1 A_IN(14)
#define A_CONVW A_IN(15)
#define A_CONVB A_IN(16)
#define A_GWA A_IN(17)
#define A_GBA A_IN(18)
#define A_GWX A_IN(19)
#define A_GBX A_IN(20)
#define A_LAM A_IN(21)
#define A_WOUT1 A_IN(22)
#define W_BF(off) ((bf16*)(A->ws + (off)))
#define W_WIN0T W_BF(WS_WIN0)
#define W_WOUT0T W_BF(WS_WOUT0)
#define W_WIN1T W_BF(WS_WIN1)
#define W_WOUT1T W_BF(WS_WOUT1)
#define W_ROPE ((float*)(A->ws + WS_ROPE))
#define W_XN W_BF(WS_XN)
#define W_MIX W_BF(WS_MIX)
#define W_QA W_BF(WS_R1 + R_QA)
#define W_GA W_BF(WS_R1 + R_GA)
#define W_QB W_BF(WS_R1 + R_QB)
#define W_KB W_BF(WS_R1 + R_KB)
#define W_VB W_BF(WS_R1 + R_VB)
#define W_GB W_BF(WS_R1 + R_GB)
#define W_KA W_BF(WS_R1 + R_KA)
#define W_VA W_BF(WS_R1 + R_VA)
#define W_KAS W_BF(WS_R1 + R_KAS)
#define W_VAS W_BF(WS_R1 + R_VAS)
#define W_KBS W_BF(WS_R1 + R_KBS)
#define W_VBS W_BF(WS_R1 + R_VBS)
#define W_M1 ((float*)(A->ws + WS_R1 + R_M1))
#define W_XB W_BF(WS_R1 + R_XB)
#define W_ZB W_BF(WS_R1 + R_ZB)
__device__ __forceinline__ const float* x_row(CArgs A, int m) { return m < MP ? A_XP + (size_t)m * DM : A_XS + (size_t)(m - MP) * DM; }

__device__ __forceinline__ float wave_sum(float v) {
#pragma unroll
    for (int o = 1; o < 64; o <<= 1) v += __shfl_xor(v, o);
    return v;
}
__device__ __forceinline__ float bf2f(unsigned short b) { return __uint_as_float((unsigned)b << 16); }
__device__ __forceinline__ float bflo(unsigned w) { return __uint_as_float(w << 16); }
__device__ __forceinline__ float bfhi(unsigned w) { return __uint_as_float(w & 0xffff0000u); }

__host__ __device__ __forceinline__ int rope_perm_col(int d) { const int n = d >> 5, w = (d >> 4) & 1, fq = (d >> 2) & 3, j = d & 3; return 32 * w + 8 * fq + 4 * n + j; }
__host__ __device__ __forceinline__ int win0_row(int n) { return n < 640 ? (n & ~63) + rope_perm_col(n & 63) : n; }

template <int MAP>
__device__ __forceinline__ void p0_transpose_item(const float* W, int K, int N, bf16* WT, LAS float* scr, int item, int lane) {
    const int nblk = N / 32, kb = item / nblk, nb = item % nblk, k0 = 64 * kb, n0 = 32 * nb;
#pragma unroll 8
    for (int i = 0; i < 32; ++i) { const int kk = 2 * i + (lane >> 5); scr[kk * 33 + (lane & 31)] = W[(size_t)(k0 + kk) * N + n0 + (lane & 31)]; }
    LDS_WAIT(); asm volatile("" ::: "memory");
    const int c = lane & 7;
#pragma unroll
    for (int j = 0; j < 4; ++j) { const int n = (lane >> 3) + 8 * j; const LAS float* s = scr + (8 * c) * 33 + n;
        v4u o; o.x = pk2(s[0 * 33], s[1 * 33]); o.y = pk2(s[2 * 33], s[3 * 33]); o.z = pk2(s[4 * 33], s[5 * 33]); o.w = pk2(s[6 * 33], s[7 * 33]);
        const int drow = MAP ? win0_row(n0 + n) : (n0 + n);
        *(GAS v4u*)(WT + (size_t)drow * K + k0 + 8 * c) = o; }
    LDS_WAIT(); asm volatile("" ::: "memory");
}
__device__ __forceinline__ void rms_row_to_bf16(int lane, const float* xrow, const float* g, bf16* orow) {
    const GAS f32x4* xr = (const GAS f32x4*)xrow + lane; const GAS f32x4* gr = (const GAS f32x4*)g + lane;
    f32x4 v[4]; float s = 0.f;
#pragma unroll
    for (int j = 0; j < 4; ++j) { v[j] = xr[64 * j]; s += (v[j].x * v[j].x + v[j].y * v[j].y) + (v[j].z * v[j].z + v[j].w * v[j].w); }
    const float rstd = 1.0f / sqrtf(wave_sum(s) * (1.f / DM) + EPS);
    GAS unsigned long long* o8 = (GAS unsigned long long*)orow + lane;
#pragma unroll
    for (int j = 0; j < 4; ++j) { const f32x4 gg = gr[64 * j]; const f32x4 y = v[j] * rstd * gg; o8[64 * j] = (unsigned long long)pk2(y.x, y.y) | ((unsigned long long)pk2(y.z, y.w) << 32); }
}
__constant__ float kRopeInv[32] = {0x1.0000000000000p+0f, 0x1.7ff2240000000p-1f, 0x1.1feb340000000p-1f, 0x1.afd1360000000p-2f, 0x1.43d1360000000p-2f, 0x1.e5a8480000000p-3f, 0x1.6c310e0000000p-3f, 0x1.111aec0000000p-3f,
    0x1.99999a0000000p-4f, 0x1.33281a0000000p-4f, 0x1.ccab860000000p-5f, 0x1.59742c0000000p-5f, 0x1.030dc40000000p-5f, 0x1.8486a00000000p-6f, 0x1.235a720000000p-6f, 0x1.b4f7e40000000p-7f,
    0x1.47ae140000000p-7f, 0x1.eb735e0000000p-8f, 0x1.7089380000000p-8f, 0x1.145cee0000000p-8f, 0x1.9e7c6e0000000p-9f, 0x1.36d2180000000p-9f, 0x1.d22a500000000p-10f, 0x1.5d931c0000000p-10f,
    0x1.0624de0000000p-10f, 0x1.89291a0000000p-11f, 0x1.26d42c0000000p-11f, 0x1.ba2e4c0000000p-12f, 0x1.4b96be0000000p-12f, 0x1.f150280000000p-13f, 0x1.74eea60000000p-13f, 0x1.17a8e40000000p-13f};
__device__ __forceinline__ void sincos_acc(float angf, float& c, float& s) {
    const double a = (double)angf; const double k = __builtin_rint(a * 0.63661977236758134308);
    const double r = __builtin_fma(-k, 6.123233995736766e-17, __builtin_fma(-k, 1.5707963267948966, a));
    const double r2 = r * r;
    double sp = -1.0 / 1307674368000.0; sp = sp * r2 + 1.0 / 6227020800.0; sp = sp * r2 - 1.0 / 39916800.0; sp = sp * r2 + 1.0 / 362880.0; sp = sp * r2 - 1.0 / 5040.0; sp = sp * r2 + 1.0 / 120.0; sp = sp * r2 - 1.0 / 6.0; sp = sp * r2 + 1.0;
    const double sr = sp * r;
    double cp = 1.0 / 20922789888000.0; cp = cp * r2 - 1.0 / 87178291200.0; cp = cp * r2 + 1.0 / 479001600.0; cp = cp * r2 - 1.0 / 3628800.0; cp = cp * r2 + 1.0 / 40320.0; cp = cp * r2 - 1.0 / 720.0; cp = cp * r2 + 1.0 / 24.0; cp = cp * r2 - 0.5; cp = cp * r2 + 1.0;
    const int q = ((int)k) & 3;
    const double cc = (q == 0) ? cp : (q == 1) ? -sr : (q == 2) ? -cp : sr;
    const double ss = (q == 0) ? sr : (q == 1) ? cp : (q == 2) ? -sr : -cp;
    c = (float)cc; s = (float)ss;
}

__device__ __forceinline__ void p0_prologue(Frame& F, CArgs A) {
    LAS float* scr = (LAS float*)(F.lds + RING_OFF + F.wave * 16384);
    const int gw = F.vcu * NWAVES + F.wave, NGW = F.G * NWAVES;
    constexpr int I_0 = (DM / 64) * (NIN / 32), I_1 = (DM / 64) * (DM / 32), I_2 = (DM / 64) * (2 * DM / 32), I_3 = I_1;
    constexpr int NITEMS = I_0 + I_1 + I_2 + I_3;
    for (int it = gw; it < NITEMS; it += NGW) {
        int r = it;
        if (r < I_0) { p0_transpose_item<1>(A_WIN0, DM, NIN, W_WIN0T, scr, r, F.lane); continue; } r -= I_0;
        if (r < I_1) { p0_transpose_item<0>(A_WOUT0, DM, DM, W_WOUT0T, scr, r, F.lane); continue; } r -= I_1;
        if (r < I_2) { p0_transpose_item<0>(A_WIN1, DM, 2 * DM, W_WIN1T, scr, r, F.lane); continue; } r -= I_2;
        p0_transpose_item<0>(A_WOUT1, DM, DM, W_WOUT1T, scr, r, F.lane);
    }
    for (int m = gw; m < M; m += NGW) rms_row_to_bf16(F.lane, x_row(A, m), A_LNPRE, W_XN + (size_t)m * DM);
    const int gt = gw * 64 + F.lane, NGT = NGW * 64;
    for (int i = gt; i < 2048 * 32; i += NGT) { const int pos = i >> 5, k = i & 31; const float ang = (float)pos * kRopeInv[k]; float c, s; sincos_acc(ang, c, s); W_ROPE[pos * 64 + k] = c; W_ROPE[pos * 64 + 32 + k] = s; }
    for (int i = gt; i < 32 * 128 * 128 / 4; i += NGT) {
        const int e = i * 4, b = e >> 14, r = (e >> 7) & 127, col = e & 127;
        const f32x4 k4 = *(const GAS f32x4*)(A_CAK + e), v4 = *(const GAS f32x4*)(A_CAV + e);
        const size_t bo = (size_t)(b * 160 + r) * 128 + col;
        *(GAS unsigned long long*)(W_KAS + bo) = (unsigned long long)pk2(k4.x, k4.y) | ((unsigned long long)pk2(k4.z, k4.w) << 32);
        *(GAS unsigned long long*)(W_VAS + bo) = (unsigned long long)pk2(v4.x, v4.y) | ((unsigned long long)pk2(v4.z, v4.w) << 32);
        if (r >= 32) { const size_t fo = (size_t)(b * 128 + r - 32) * 128 + col; *(GAS f32x4*)(A->out + O_AKS + fo) = k4; *(GAS f32x4*)(A->out + O_AVS + fo) = v4; }
    }
    for (int i = gt; i < 32 * 512 * 512 / 4; i += NGT) {
        const int e = i * 4, b = e >> 18, r = (e >> 9) & 511, col = e & 511;
        const f32x4 k4 = *(const GAS f32x4*)(A_CBK + e), v4 = *(const GAS f32x4*)(A_CBV + e);
        const size_t bo = (size_t)(b * 544 + r) * 512 + col;
        *(GAS unsigned long long*)(W_KBS + bo) = (unsigned long long)pk2(k4.x, k4.y) | ((unsigned long long)pk2(k4.z, k4.w) << 32);
        *(GAS unsigned long long*)(W_VBS + bo) = (unsigned long long)pk2(v4.x, v4.y) | ((unsigned long long)pk2(v4.z, v4.w) << 32);
        if (r >= 32) { const size_t fo = (size_t)(b * 512 + r - 32) * 512 + col; *(GAS f32x4*)(A->out + O_BKS + fo) = k4; *(GAS f32x4*)(A->out + O_BVS + fo) = v4; }
    }
}

__device__ __forceinline__ void attn_simple_phase(Frame& F, CArgs A) {
    LAS float* Kt = (LAS float*)(F.lds + RING_OFF + F.wave * 16384); LAS float* Vt = Kt + 2048;
    int lane0 = F.lane;
    const int gw = F.vcu * NWAVES + F.wave, NGW = F.G * NWAVES;
    constexpr int NITEM = 16 * 32 * 16 * 2 + 32 * 16;
    for (int item = gw; item < NITEM; item += NGW) {
        int lane = lane0; asm volatile("" : "+v"(lane));
        const bool sample = item >= 16384; int b, c, hh, qh;
        if (sample) { const int i2 = item - 16384; b = i2 >> 4; hh = i2 & 15; c = 0; qh = 0; } else { b = item >> 10; c = (item >> 5) & 31; hh = (item >> 1) & 15; qh = item & 1; }
        const bool isB = hh >= 8; const int h = hh & 7;
        const int ql = (lane & 31) + 32 * qh, dh = lane >> 5;
        const size_t qrow = sample ? (size_t)(MP + b * 32 + ql) : (size_t)(b * 2048 + c * 64 + ql);
        const bf16* qp = (isB ? W_QB : W_QA) + qrow * 512 + h * 64 + dh * 32;
        float q[32];
#pragma unroll
        for (int i = 0; i < 4; ++i) { const v4u w = *(const GAS v4u*)(qp + 8 * i); q[8 * i] = bflo(w.x); q[8 * i + 1] = bfhi(w.x); q[8 * i + 2] = bflo(w.y); q[8 * i + 3] = bfhi(w.y); q[8 * i + 4] = bflo(w.z); q[8 * i + 5] = bfhi(w.z); q[8 * i + 6] = bflo(w.w); q[8 * i + 7] = bfhi(w.w); }
        const bf16 *kb, *vb; int pitch, s_lo, s_hi, kpos0;
        if (!sample) {
            if (isB) { kb = W_KB + (size_t)b * 2048 * 512 + h * 64; vb = W_VB + (size_t)b * 2048 * 512 + h * 64; pitch = 512; s_lo = (c - 8) * 64; }
            else { kb = W_KA + (size_t)b * 2048 * 128 + (h >> 2) * 64; vb = W_VA + (size_t)b * 2048 * 128 + (h >> 2) * 64; pitch = 128; s_lo = (c - 2) * 64; }
            if (s_lo < 0) s_lo = 0; s_hi = (c + 1) * 64; kpos0 = 0;
        } else {
            if (isB) { kb = W_KBS + (size_t)b * 544 * 512 + h * 64; vb = W_VBS + (size_t)b * 544 * 512 + h * 64; pitch = 512; s_hi = 544; kpos0 = 512; }
            else { kb = W_KAS + (size_t)b * 160 * 128 + (h >> 2) * 64; vb = W_VAS + (size_t)b * 160 * 128 + (h >> 2) * 64; pitch = 128; s_hi = 160; kpos0 = 896; }
            s_lo = 0;
        }
        const int qpos = sample ? PAST + ql : c * 64 + ql;
        const float* relb = A_RELPOS + h * 257;
        float mrun = -1e30f, l = 0.f; float o[32];
#pragma unroll
        for (int i = 0; i < 32; ++i) o[i] = 0.f;
        for (int s0 = s_lo; s0 < s_hi; s0 += 32) {
            { const int key = lane >> 1, half = lane & 1; const bf16* ks = kb + (size_t)(s0 + key) * pitch + half * 32; const bf16* vs = vb + (size_t)(s0 + key) * pitch + half * 32;
              LAS float* kd = Kt + key * 64 + half * 32; LAS float* vd = Vt + key * 64 + half * 32;
#pragma unroll
              for (int i = 0; i < 4; ++i) { const v4u kw = *(const GAS v4u*)(ks + 8 * i), vw = *(const GAS v4u*)(vs + 8 * i);
                  *(LAS f32x4*)(kd + 8 * i) = (f32x4){bflo(kw.x), bfhi(kw.x), bflo(kw.y), bfhi(kw.y)}; *(LAS f32x4*)(kd + 8 * i + 4) = (f32x4){bflo(kw.z), bfhi(kw.z), bflo(kw.w), bfhi(kw.w)};
                  *(LAS f32x4*)(vd + 8 * i) = (f32x4){bflo(vw.x), bfhi(vw.x), bflo(vw.y), bfhi(vw.y)}; *(LAS f32x4*)(vd + 8 * i + 4) = (f32x4){bflo(vw.z), bfhi(vw.z), bflo(vw.w), bfhi(vw.w)}; } }
            LDS_WAIT(); asm volatile("" ::: "memory");
#pragma unroll 1
            for (int k = 0; k < 32; ++k) {
                float a = 0.f; const LAS f32x4* kr = (const LAS f32x4*)(Kt + k * 64 + dh * 32);
#pragma unroll
                for (int d4 = 0; d4 < 8; ++d4) { const f32x4 kv = kr[d4]; a += q[4 * d4] * kv.x; a += q[4 * d4 + 1] * kv.y; a += q[4 * d4 + 2] * kv.z; a += q[4 * d4 + 3] * kv.w; }
                a += __shfl_xor(a, 32);
                if (isB) { int rel = qpos - (kpos0 + s0 + k); rel = rel < -128 ? -128 : (rel > 128 ? 128 : rel); a += relb[rel + 128] * LOG2E; }
                if (a > mrun) { const float scale = __builtin_amdgcn_exp2f(mrun - a); mrun = a; l *= scale;
#pragma unroll
                    for (int i = 0; i < 32; ++i) o[i] *= scale; }
                const float p = __builtin_amdgcn_exp2f(a - mrun); l += p; const LAS f32x4* vr = (const LAS f32x4*)(Vt + k * 64 + dh * 32);
#pragma unroll
                for (int d4 = 0; d4 < 8; ++d4) { const f32x4 vv = vr[d4]; o[4 * d4] += p * vv.x; o[4 * d4 + 1] += p * vv.y; o[4 * d4 + 2] += p * vv.z; o[4 * d4 + 3] += p * vv.w; }
            }
            LDS_WAIT(); asm volatile("" ::: "memory");
        }
        if (!isB) { const float sk = A_SINKS[h] * LOG2E, mf = fmaxf(mrun, sk), scale = __builtin_amdgcn_exp2f(mrun - mf); l = l * scale + __builtin_amdgcn_exp2f(sk - mf);
#pragma unroll
            for (int i = 0; i < 32; ++i) o[i] *= scale; }
        const float inv = 1.0f / l;
        {
            const bf16* gp = (isB ? W_GB : W_GA) + qrow * 512 + h * 64 + dh * 32; bf16* mp = W_MIX + qrow * 1024 + (isB ? 512 : 0) + h * 64 + dh * 32;
#pragma unroll
            for (int i = 0; i < 4; ++i) { const v4u g = *(const GAS v4u*)(gp + 8 * i); v4u w;
                w.x = pk2(o[8 * i] * inv * bflo(g.x), o[8 * i + 1] * inv * bfhi(g.x)); w.y = pk2(o[8 * i + 2] * inv * bflo(g.y), o[8 * i + 3] * inv * bfhi(g.y));
                w.z = pk2(o[8 * i + 4] * inv * bflo(g.z), o[8 * i + 5] * inv * bfhi(g.z)); w.w = pk2(o[8 * i + 6] * inv * bflo(g.w), o[8 * i + 7] * inv * bfhi(g.w));
                *(GAS v4u*)(mp + 8 * i) = w; }
        }
    }
}

template <bool NEXT>
__device__ __forceinline__ void rowpass_phase(Frame& F, CArgs A, const float* Mbuf, int layer) {
    int lane = F.lane; asm volatile("" : "+v"(lane));
    const int gw = F.vcu * NWAVES + F.wave, NGW = F.G * NWAVES;
    const GAS f32x4* gp = (const GAS f32x4*)(A_LNPOST + layer * DM) + lane; const GAS f32x4* gn = (const GAS f32x4*)(A_LNPRE + (layer + 1) * DM) + lane;
    for (int m = gw; m < M; m += NGW) {
        const GAS f32x4* mr = (const GAS f32x4*)(Mbuf + (size_t)m * DM) + lane;
        const GAS f32x4* br = (const GAS f32x4*)(layer == 0 ? x_row(A, m) : A->out + (size_t)m * DM) + lane;
        GAS f32x4* yo = (GAS f32x4*)(A->out + (size_t)m * DM) + lane;
        f32x4 v[4], y[4]; float s = 0.f;
#pragma unroll
        for (int j = 0; j < 4; ++j) { v[j] = mr[64 * j]; y[j] = br[64 * j]; s += (v[j].x * v[j].x + v[j].y * v[j].y) + (v[j].z * v[j].z + v[j].w * v[j].w); }
        const float rstd = 1.0f / sqrtf(wave_sum(s) * (1.f / DM) + EPS); float s2 = 0.f;
#pragma unroll
        for (int j = 0; j < 4; ++j) { y[j] = y[j] + v[j] * rstd * gp[64 * j]; yo[64 * j] = y[j]; s2 += (y[j].x * y[j].x + y[j].y * y[j].y) + (y[j].z * y[j].z + y[j].w * y[j].w); }
        if (NEXT) {
            const float r2 = 1.0f / sqrtf(wave_sum(s2) * (1.f / DM) + EPS);
            GAS unsigned long long* o8 = (GAS unsigned long long*)(W_XN + (size_t)m * DM) + lane;
#pragma unroll
            for (int j = 0; j < 4; ++j) { const f32x4 z = y[j] * r2 * gn[64 * j]; o8[64 * j] = (unsigned long long)pk2(z.x, z.y) | ((unsigned long long)pk2(z.z, z.w) << 32); }
        }
    }
}

__device__ __forceinline__ float sigmoid_f(float v) { return 1.0f / (1.0f + __expf(-v)); }
__device__ __forceinline__ void lru_phase(Frame& F, CArgs A) {
    int lane = F.lane; asm volatile("" : "+v"(lane)); const int w = F.wave;
    LAS float* xcs = (LAS float*)(F.lds + RING_OFF) + w * 3072;
    LAS float* as_ = xcs + 1024; LAS float* us_ = xcs + 2048;
    LAS float* segs = (LAS float*)(F.lds + RING_OFF + 98304);
    for (int unit = blockIdx.x; unit < 768; unit += F.G) {
        const bool sample = unit >= 256; const int uu = sample ? unit - 256 : unit; const int b = uu >> 4, n = uu & 15;
        const int T = sample ? DEC_T : SEQ; const int m0 = sample ? MP + b * DEC_T : b * SEQ; const int ch = n * 64 + lane;
        float wa[64], wx[64];
#pragma unroll
        for (int i = 0; i < 64; ++i) { wa[i] = A_GWA[(size_t)n * 4096 + i * 64 + lane]; wx[i] = A_GWX[(size_t)n * 4096 + i * 64 + lane]; }
        const float ba = A_GBA[ch], bx = A_GBX[ch], cb = A_CONVB[ch];
        const float cw0 = A_CONVW[ch], cw1 = A_CONVW[DM + ch], cw2 = A_CONVW[2 * DM + ch], cw3 = A_CONVW[3 * DM + ch];
        const float lamv = A_LAM[ch]; const float c8 = -8.0f * log1pf(expf(-lamv));
        float hcar = sample ? A_STH[(size_t)b * DM + ch] : 0.f;
        const int ntile = (T + 127) / 128;
        for (int tile = 0; tile < ntile; ++tile) {
            const int t0 = tile * 128 + w * 16; const bool act = t0 < T;
            float xm3 = 0.f, xm2 = 0.f, xm1 = 0.f; float Aseg = 1.f, H = 0.f;
            if (act) {
                if (t0 >= 3) { xm3 = bf2f(W_XB[(size_t)(m0 + t0 - 3) * DM + ch]); xm2 = bf2f(W_XB[(size_t)(m0 + t0 - 2) * DM + ch]); xm1 = bf2f(W_XB[(size_t)(m0 + t0 - 1) * DM + ch]); }
                else if (sample) { xm3 = A_STCONV[(size_t)(b * 3 + 0) * DM + ch]; xm2 = A_STCONV[(size_t)(b * 3 + 1) * DM + ch]; xm1 = A_STCONV[(size_t)(b * 3 + 2) * DM + ch]; }
                for (int tk = 0; tk < 16; ++tk) {
                    const float xc0 = bf2f(W_XB[(size_t)(m0 + t0 + tk) * DM + ch]);
                    xcs[tk * 64 + lane] = cb + cw0 * xm3 + cw1 * xm2 + cw2 * xm1 + cw3 * xc0;
                    xm3 = xm2; xm2 = xm1; xm1 = xc0;
                }
                LDS_WAIT(); asm volatile("" ::: "memory");
                for (int tk = 0; tk < 16; ++tk) {
                    float ga = ba, gx = bx; const LAS f32x4* xr = (const LAS f32x4*)(xcs + tk * 64);
#pragma unroll
                    for (int i4 = 0; i4 < 16; ++i4) { const f32x4 xv = xr[i4];
                        ga += xv.x * wa[4 * i4]; ga += xv.y * wa[4 * i4 + 1]; ga += xv.z * wa[4 * i4 + 2]; ga += xv.w * wa[4 * i4 + 3];
                        gx += xv.x * wx[4 * i4]; gx += xv.y * wx[4 * i4 + 1]; gx += xv.z * wx[4 * i4 + 2]; gx += xv.w * wx[4 * i4 + 3]; }
                    const float r = sigmoid_f(ga), gi = sigmoid_f(gx); const float la = c8 * r; const float a = expf(la);
                    const float uu2 = sqrtf(-expm1f(2.0f * la)) * (gi * xcs[tk * 64 + lane]);
                    as_[tk * 64 + lane] = a; us_[tk * 64 + lane] = uu2; H = a * H + uu2; Aseg *= a;
                }
            }
            LAS float* sg = segs + (tile & 1) * 1024;
            sg[w * 128 + lane] = Aseg; sg[w * 128 + 64 + lane] = H;
            LDS_WAIT(); __syncthreads();
            float hin = hcar, hall = hcar;
#pragma unroll
            for (int ww = 0; ww < 8; ++ww) { const float Aw = sg[ww * 128 + lane], Hw = sg[ww * 128 + 64 + lane]; hall = Aw * hall + Hw; if (ww < w) hin = Aw * hin + Hw; }
            hcar = hall;
            if (act) {
                float h = hin;
                for (int tk = 0; tk < 16; ++tk) {
                    h = as_[tk * 64 + lane] * h + us_[tk * 64 + lane];
                    const size_t o = (size_t)(m0 + t0 + tk) * DM + ch;
                    W_MIX[o] = (bf16)f2bf(h * bf2f(W_ZB[o]));
                }
                if (t0 + 16 == T) {
                    float* cc = A->out + (sample ? O_CCS : O_CCP) + (size_t)(b * 3) * DM + ch; cc[0] = xm3; cc[DM] = xm2; cc[2 * DM] = xm1; }
            }
        }
        if (w == 0) A->out[(sample ? O_CHS : O_CHP) + (size_t)b * DM + ch] = hcar;
        __syncthreads();
    }
}

#ifndef MK_N_LAUNCHES
#define MK_N_LAUNCHES 1
#endif
constexpr int PER_PHASE = 9;
constexpr int N_LAUNCHES = MK_N_LAUNCHES;
__global__ void __launch_bounds__(NWAVES * 64, 2) hybrid_fwd(Args A_) {
    extern __shared__ __attribute__((aligned(16))) unsigned char lds[];
    Frame F;
    F.lds = (LAS unsigned char*)lds;
    F.MISC = (volatile LAS unsigned*)(F.lds + MISC_OFF);
    F.tid = threadIdx.x; F.lane = F.tid & 63; F.wave = __builtin_amdgcn_readfirstlane(F.tid >> 6);
    F.G = gridDim.x; { const int bx = blockIdx.x; F.vcu = (F.G % 8 == 0) ? (bx % 8) * (F.G / 8) + bx / 8 : bx; }
    F.ctl = (gu32*)(A_.ws + WS_CTL);
    for (int u = F.tid; u < (LDS_BYTES - LDSCTL_OFF) / 4; u += NWAVES * 64) ((LAS unsigned*)(F.lds + LDSCTL_OFF))[u] = 0u;
    __syncthreads();
    XcdBarrier bar; bar.bar = (unsigned*)(F.ctl + CW_BAR); bar.x = 0; bar.st = nullptr;
    if (N_LAUNCHES == 1) bar = xcd_barrier_post((unsigned*)(F.ctl + CW_BAR), F.MISC + 8);
#define GRID_BAR() do { if (N_LAUNCHES == 1) xcd_barrier(bar); } while (0)
    const int lo = A_.ph_lo, hi = A_.ph_hi;
#ifndef PHMASK
#define PHMASK 0x1ff
#endif
#define IN(k) (((PHMASK >> (k)) & 1) && lo <= (k) && (k) < hi)
#define BOTH(k) (IN(k) && IN((k) + 1))

    if (IN(0)) { CArgs A = kargs(); p0_prologue(F, A); if (BOTH(0)) GRID_BAR(); }
    if (IN(1)) { CArgs A = kargs();
        pg8::Gemm g{W_XN, W_WIN0T, M, NIN, DM}; pg8::StaticOrder S; S.init(M, NIN, F.G, (int)blockIdx.x);
        pg8::EpiQKV E{W_QA, W_KA, W_VA, W_GA, W_QB, W_KB, W_VB, W_GB, W_KAS, W_VAS, W_KBS, W_VBS, W_ROPE, A->out};
        pg8::gemm_phase<pg8::EpiQKV, pg8::StaticOrder, true, true>(F.lds + RING_OFF, g, S, E);
        if (BOTH(1)) GRID_BAR();
    }
    if (IN(2)) { CArgs A = kargs(); attn_simple_phase(F, A); if (BOTH(2)) GRID_BAR(); }
    if (IN(3)) { CArgs A = kargs();
        pg8::Gemm g{W_MIX, W_WOUT0T, M, DM, DM}; pg8::StaticOrder S; S.init(M, DM, F.G, (int)blockIdx.x);
        pg8::EpiF32 E{W_M1, DM};
        pg8::gemm_phase<pg8::EpiF32, pg8::StaticOrder, true, true>(F.lds + RING_OFF, g, S, E);
        if (BOTH(3)) GRID_BAR();
    }
    if (IN(4)) { CArgs A = kargs(); rowpass_phase<true>(F, A, W_M1, 0); if (BOTH(4)) GRID_BAR(); }
    if (IN(5)) { CArgs A = kargs();
        pg8::Gemm g{W_XN, W_WIN1T, M, 2 * DM, DM}; pg8::StaticOrder S; S.init(M, 2 * DM, F.G, (int)blockIdx.x);
        pg8::EpiXZ E{W_XB, W_ZB};
        pg8::gemm_phase<pg8::EpiXZ, pg8::StaticOrder, true, true>(F.lds + RING_OFF, g, S, E);
        if (BOTH(5)) GRID_BAR();
    }
    if (IN(6)) { CArgs A = kargs(); lru_phase(F, A); if (BOTH(6)) GRID_BAR(); }
    if (IN(7)) { CArgs A = kargs();
        pg8::Gemm g{W_MIX, W_WOUT1T, M, DM, DM}; pg8::StaticOrder S; S.init(M, DM, F.G, (int)blockIdx.x);
        pg8::EpiF32 E{W_M1, DM};
        pg8::gemm_phase<pg8::EpiF32, pg8::StaticOrder, true, true>(F.lds + RING_OFF, g, S, E);
        if (BOTH(7)) GRID_BAR();
    }
    if (IN(8)) { CArgs A = kargs(); rowpass_phase<false>(F, A, W_M1, 1); }
#undef IN
#undef BOTH
}

extern "C" void kernel_launch(void* const* d_in, const int* in_sizes, int n_in, void* d_out, int out_size, void* d_ws, size_t ws_size, hipStream_t stream) {
    static int grid = 0;
    if (grid == 0) {
        if (n_in != 23 || in_sizes[0] != MP * DM || (size_t)out_size != O_END || ws_size < WS_END) { fprintf(stderr, "kernel_launch: unexpected shapes: n_in %d in0 %d out %d ws %zu\n", n_in, n_in > 0 ? in_sizes[0] : -1, out_size, ws_size); grid = -1; return; }
        int dev = 0, cus = 0, per_cu = 0;
        if (hipGetDevice(&dev) != hipSuccess || hipDeviceGetAttribute(&cus, hipDeviceAttributeMultiprocessorCount, dev) != hipSuccess) { grid = -1; return; }
        if (hipFuncSetAttribute((const void*)hybrid_fwd, hipFuncAttributeMaxDynamicSharedMemorySize, LDS_BYTES) != hipSuccess) { fprintf(stderr, "kernel_launch: hipFuncSetAttribute failed\n"); grid = -1; return; }
        if (hipOccupancyMaxActiveBlocksPerMultiprocessor(&per_cu, (const void*)hybrid_fwd, NWAVES * 64, LDS_BYTES) != hipSuccess || per_cu < 1) fprintf(stderr, "kernel_launch: occupancy query reports %d blocks per CU\n", per_cu);
        (void)hipGetLastError();
        grid = cus;
    }
    if (grid < 0) return;
    if (hipMemsetAsync((char*)d_ws + WS_CTL, 0, CTL_ZERO_BYTES, stream) != hipSuccess) { fprintf(stderr, "kernel_launch: memset failed\n"); return; }
    Args a{};
    for (int i = 0; i < 23; ++i) a.in[i] = (const float*)d_in[i];
    a.out = (float*)d_out; a.ws = (unsigned char*)d_ws;
    for (int li = 0; li < N_LAUNCHES; ++li) {
        a.ph_lo = (N_LAUNCHES == 1) ? 0 : li; a.ph_hi = (N_LAUNCHES == 1) ? PER_PHASE : li + 1;
        hipLaunchKernelGGL(hybrid_fwd, dim3(grid), dim3(NWAVES * 64), LDS_BYTES, stream, a);
        const hipError_t le = hipPeekAtLastError();
        if (le != hipSuccess) { fprintf(stderr, "kernel_launch: launch %d failed: %s\n", li, hipGetErrorName(le)); break; }
    }
}
```

```cpp
#include <hip/hip_runtime.h>
#include <cstdio>
#include <cstdint>
namespace pg8 {
#define PG8_LAS __attribute__((address_space(3)))
typedef unsigned short bf16_t;
typedef short bf16x8 __attribute__((ext_vector_type(8)));
typedef float f32x4 __attribute__((ext_vector_type(4)));
typedef unsigned u32x4 __attribute__((ext_vector_type(4)));
constexpr int BM = 256, BK = 64, HALF = 128, HTB = HALF * BK * 2  , STAGE_BYTES = 8 * HTB, NXCD = 8, WGM = 8;

__host__ __device__ __forceinline__ int lds_byte(int r, int c) { const int st = (r >> 4) * 2 + (c >> 5), rr = r & 15, cc = c & 31, ob = rr * 64 + cc * 2; return st * 1024 + (ob ^ (((ob >> 9) & 1) << 5)); }
__host__ __device__ __forceinline__ void stage_rc(int b, int& R, int& C) { const int st = b / 1024, sb = b % 1024, swz = sb ^ (((sb >> 9) & 1) << 5); R = (st >> 1) * 16 + swz / 64; C = (st & 1) * 32 + (swz % 64) / 2; }
__host__ __device__ __forceinline__ int perm32(int rho) { const int n = rho >> 4, i = rho & 15; return 8 * (i >> 2) + 4 * n + (i & 3); }

struct Unit { int pm, pn; };
struct Gemm { const bf16_t* A; const bf16_t* Bt; int M, N, K; int a_ld; size_t a_kstep; };

struct StaticOrder {
    int nM, nN, nwg, G, c;
    __host__ __device__ void init(int M, int N, int G_, int c_) { nM = M / BM; nN = N / BM; nwg = nM * nN; G = G_; c = c_; }
    __host__ __device__ bool next(int i, Unit& u) const {
        const long L = (long)i * G + c; if (L >= nwg) return false;
        int wgid = (int)L; { const int q = nwg / NXCD, r = nwg % NXCD, xcd = wgid % NXCD, off = wgid / NXCD; wgid = (xcd < r ? xcd * (q + 1) : r * (q + 1) + (xcd - r) * q) + off; }
        const int nig = WGM * nN, gid = wgid / nig, fm = gid * WGM, gsz = (nM - fm) < WGM ? (nM - fm) : WGM;
        u.pm = fm + ((wgid % nig) % gsz); u.pn = (wgid % nig) / gsz; return true;
    }
    __device__ __forceinline__ void a_ready(const Unit&) const {}
    __device__ __forceinline__ void done(const Unit&) const {}
};

struct DynOrder : StaticOrder {
    unsigned* head; PG8_LAS unsigned* slot;
    __device__ __forceinline__ bool next(int i, Unit& u) const {
        unsigned k;
        if (i == 0) k = (unsigned)(c / NXCD);
        else {
            if (threadIdx.x < 64) { unsigned t = 0; if (threadIdx.x == 0) t = __hip_atomic_fetch_add(head + 64 * (c % NXCD), 1u, __ATOMIC_RELAXED, __HIP_MEMORY_SCOPE_AGENT);
                t = (unsigned)__builtin_amdgcn_readfirstlane((int)t); if (threadIdx.x == 0) *slot = t + (unsigned)(G / NXCD); asm volatile("s_waitcnt lgkmcnt(0)" ::: "memory"); }
            asm volatile("" ::: "memory"); __builtin_amdgcn_s_barrier(); asm volatile("" ::: "memory");
            k = *(volatile PG8_LAS unsigned*)slot;
        }
        const long L = (long)k * NXCD + (c % NXCD); if (L >= nwg) return false;
        int wgid = (int)L; { const int q = nwg / NXCD, r = nwg % NXCD, xcd = wgid % NXCD, off = wgid / NXCD; wgid = (xcd < r ? xcd * (q + 1) : r * (q + 1) + (xcd - r) * q) + off; }
        const int nig = WGM * nN, gid = wgid / nig, fm = gid * WGM, gsz = (nM - fm) < WGM ? (nM - fm) : WGM;
        u.pm = fm + ((wgid % nig) % gsz); u.pn = (wgid % nig) / gsz; return true;
    }
};

__device__ __forceinline__ unsigned cvt_pk_bf16(float lo, float hi) { unsigned r; asm volatile("v_cvt_pk_bf16_f32 %0, %1, %2" : "=v"(r) : "v"(lo), "v"(hi)); return r; }
typedef float f32x2 __attribute__((ext_vector_type(2)));

constexpr int EP_MP = 32768, EP_PAST = 1024, EP_M = 33792;
constexpr float EP_C2 = 0.125f * 1.4426950408889634f;
constexpr size_t ER_SZ512 = (size_t)33792 * 512 * 2, ER_TA = (size_t)16 * 2 * 64 * 4096, ER_TB = (size_t)16 * 8 * 64 * 4096, ER_SA = (size_t)32 * 2 * 5 * 4096, ER_SB = (size_t)32 * 8 * 17 * 4096;
constexpr size_t ER_QA = 0, ER_GA = ER_QA + ER_SZ512, ER_QB = ER_GA + ER_SZ512, ER_GB = ER_QB + ER_SZ512, ER_KTA = ER_GB + ER_SZ512, ER_VTA = ER_KTA + ER_TA, ER_KTB = ER_VTA + ER_TA, ER_VTB = ER_KTB + ER_TB,
                 ER_KSA = ER_VTB + ER_TB, ER_VSA = ER_KSA + ER_SA, ER_KSB = ER_VSA + ER_SA, ER_VSB = ER_KSB + ER_SB;
constexpr size_t EO_AKP = 34603008, EO_AVP = 34865152, EO_BKP = 35127296, EO_BVP = 39321600;
constexpr size_t EO_AKS = 43581440, EO_AVS = 44105728, EO_BKS = 44630016, EO_BVS = 53018624;
__device__ __forceinline__ float silu_f(float v) { return v * __builtin_amdgcn_rcpf(1.0f + __builtin_amdgcn_exp2f(-1.4426950408889634f * v)); }
__device__ __forceinline__ f32x4 silu4(f32x4 v) { return (f32x4){silu_f(v[0]), silu_f(v[1]), silu_f(v[2]), silu_f(v[3])}; }
typedef unsigned u32x2 __attribute__((ext_vector_type(2)));
__device__ __forceinline__ u32x2 pack4(f32x4 v) { u32x2 w; w.x = cvt_pk_bf16(v[0], v[1]); w.y = cvt_pk_bf16(v[2], v[3]); return w; }
__device__ __forceinline__ u32x4 pack8(f32x4 a, f32x4 b) { u32x4 w; w.x = cvt_pk_bf16(a[0], a[1]); w.y = cvt_pk_bf16(a[2], a[3]); w.z = cvt_pk_bf16(b[0], b[1]); w.w = cvt_pk_bf16(b[2], b[3]); return w; }
__device__ __forceinline__ void st16(void* p, u32x4 v) { *(u32x4*)p = v; }
__device__ __forceinline__ void st16f(void* p, f32x4 v) { *(f32x4*)p = v; }
__device__ __forceinline__ void st8(void* p, u32x2 v) { *(u32x2*)p = v; }

struct EpiF32 {
    static constexpr bool PERM = false, AFTER_DRAIN = false;
    float* C; int ldc;
    __device__ __forceinline__ void operator()(const f32x4 (&acc)[2][2][4][2], const Unit& u, int wr, int wc, int fr, int fq) const {
        const int row0 = u.pm * BM + wr * 64 + fr, col0 = u.pn * BM + wc * 32 + 4 * fq;
#pragma unroll
        for (int ai = 0; ai < 2; ++ai)
#pragma unroll
            for (int m = 0; m < 4; ++m) { float* rowp = C + (size_t)(row0 + ai * HALF + m * 16) * ldc + col0;
#pragma unroll
                for (int bj = 0; bj < 2; ++bj)
#pragma unroll
                    for (int n = 0; n < 2; ++n) *(f32x4*)(rowp + bj * HALF + n * 16) = acc[ai][bj][m][n]; }
    }
};

struct EpiXZ {
    static constexpr bool PERM = true, AFTER_DRAIN = false;
    bf16_t* XB; bf16_t* ZB; const float* rs;
    __device__ __forceinline__ void operator()(const f32x4 (&acc)[2][2][4][2], const Unit& u, int wr, int wc, int fr, int fq) const {
        const int row0 = u.pm * BM + wr * 64 + fr; const bool isz = u.pn >= 4;
        bf16_t* base = (isz ? ZB : XB) + (size_t)((u.pn & 3) * 4 + (wc >> 1)) * ((size_t)EP_M * 64) + (wc & 1) * 32 + 8 * fq;
#pragma unroll
        for (int ai = 0; ai < 2; ++ai)
#pragma unroll
            for (int m = 0; m < 4; ++m) { const int row = row0 + ai * HALF + m * 16; bf16_t* rowp = base + (size_t)row * 64; const float sc = rs[row];
#pragma unroll
                for (int bj = 0; bj < 2; ++bj) { f32x4 v0 = acc[ai][bj][m][0] * sc, v1 = acc[ai][bj][m][1] * sc;
                    if (isz) { v0 = silu4(v0); v1 = silu4(v1); }
                    st16((void*)(rowp + (size_t)bj * 2 * ((size_t)EP_M * 64)), pack8(v0, v1)); } }
    }
};
struct EpiBf16 {
    static constexpr bool PERM = true, AFTER_DRAIN = false;
    bf16_t* C; int ldc;
    __device__ __forceinline__ void operator()(const f32x4 (&acc)[2][2][4][2], const Unit& u, int wr, int wc, int fr, int fq) const {
        const int row0 = u.pm * BM + wr * 64 + fr, col0 = u.pn * BM + wc * 32 + 8 * fq;
#pragma unroll
        for (int ai = 0; ai < 2; ++ai)
#pragma unroll
            for (int m = 0; m < 4; ++m) { bf16_t* rowp = C + (size_t)(row0 + ai * HALF + m * 16) * ldc + col0;
#pragma unroll
                for (int bj = 0; bj < 2; ++bj) st16((void*)(rowp + bj * HALF), pack8(acc[ai][bj][m][0], acc[ai][bj][m][1])); }
    }
};

struct EpiQKV {
    static constexpr bool PERM = true, AFTER_DRAIN = false;
    unsigned char* r1;
    const float* rope;
    float* out;
    __device__ __forceinline__ void operator()(const f32x4 (&acc)[2][2][4][2], const Unit& u, int wr, int wc, int fr, int fq) const {
        const int pn = u.pn; const int rowb = u.pm * BM + wr * 64 + fr; const bool sample = u.pm >= EP_MP / BM; const int w = wc & 1;
        if (pn <= 2) {
            const int dlow = 16 * w + 4 * fq;
#pragma unroll
            for (int ai = 0; ai < 2; ++ai)
#pragma unroll
                for (int m = 0; m < 4; ++m) {
                    const int row = rowb + ai * HALF + m * 16;
                    const int pos = sample ? (EP_PAST + ((row - EP_MP) & 31)) : (row & 2047);
                    const float* rp = rope + pos * 64 + dlow;
                    const f32x4 cs = *(const f32x4*)rp, sn = *(const f32x4*)(rp + 32);
                    float* fA = nullptr; size_t tA; int key;
                    if (sample) { const int rs = row - EP_MP, b = rs >> 5, t = rs & 31; fA = out + (size_t)(b * 128 + 96 + t) * 128; tA = (size_t)((b * 2 + (wc >> 1)) * 5 + 4) * 4096; key = t; }
                    else { const int b = row >> 11, t = row & 2047; if (t >= 1920) fA = out + (size_t)(b * 128 + (t - 1920)) * 128; tA = (size_t)((b * 2 + (wc >> 1)) * 64 + (t >> 5)) * 4096; key = t & 31; }
#pragma unroll
                    for (int bj = 0; bj < 2; ++bj) {
                        const f32x4 x1 = acc[ai][bj][m][0], x2 = acc[ai][bj][m][1];
                        if (pn < 2) {
                            const f32x4 o1 = (x1 * cs - x2 * sn) * EP_C2, o2 = (x2 * cs + x1 * sn) * EP_C2;
                            bf16_t* d = (bf16_t*)(r1 + ER_QA) + (size_t)row * 512 + (4 * pn + 2 * bj + (wc >> 1)) * 64 + dlow;
                            st8((void*)(d), pack4(o1)); st8((void*)(d + 32), pack4(o2));
                        } else if (bj == 0) {
                            const f32x4 o1 = x1 * cs - x2 * sn, o2 = x2 * cs + x1 * sn; const int c = (wc >> 1) * 64 + dlow;
                            unsigned char* d = r1 + (sample ? ER_KSA : ER_KTA) + tA + (2 * w + (fq >> 1)) * 512 + key * 16 + (fq & 1) * 8;
                            st8((void*)(d), pack4(o1)); st8((void*)(d + 2048), pack4(o2));
                            if (fA) { float* f = fA + (sample ? EO_AKS : EO_AKP) + c; st16f((void*)(f), o1); st16f((void*)(f + 32), o2); }
                        } else {
                            const int c = wc * 32 + 8 * fq;
                            unsigned char* d = r1 + (sample ? ER_VSA : ER_VTA) + tA + w * 2048 + key * 64 + fq * 16; st16((void*)(d), pack8(x1, x2));
                            if (fA) { float* f = fA + (sample ? EO_AVS : EO_AVP) + c; st16f((void*)(f), x1); st16f((void*)(f + 4), x2); }
                        }
                    }
                }
        } else {
            const int kind = (pn - 3) >> 1;
            const int colt = ((pn - 3) & 1) * BM + wc * 32 + 8 * fq;
            if (kind == 2 || kind == 3) {
                unsigned char* pbase = r1 + (kind == 2 ? ER_KTB : ER_VTB); unsigned char* sbase = r1 + (kind == 2 ? ER_KSB : ER_VSB);
                const size_t fo_p = kind == 2 ? EO_BKP : EO_BVP, fo_s = kind == 2 ? EO_BKS : EO_BVS;
                const int inoff = kind == 2 ? (4 * w + fq) * 512 : w * 2048 + fq * 16; const int kmul = kind == 2 ? 16 : 64;
#pragma unroll
                for (int ai = 0; ai < 2; ++ai)
#pragma unroll
                    for (int m = 0; m < 4; ++m) {
                        const int row = rowb + ai * HALF + m * 16; float* fd = nullptr; unsigned char* bd; int hstride;
                        const int h0 = ((pn - 3) & 1) * 4 + (wc >> 1);
                        if (sample) { const int rs = row - EP_MP, b = rs >> 5, t = rs & 31; fd = out + fo_s + (size_t)(b * 512 + 480 + t) * 512 + colt;
                            bd = sbase + (size_t)((b * 8 + h0) * 17 + 16) * 4096 + inoff + t * kmul; hstride = 17 * 4096; }
                        else { const int b = row >> 11, t = row & 2047; if (t >= 1536) fd = out + fo_p + (size_t)(b * 512 + (t - 1536)) * 512 + colt;
                            bd = pbase + (size_t)((b * 8 + h0) * 64 + (t >> 5)) * 4096 + inoff + (t & 31) * kmul; hstride = 64 * 4096; }
#pragma unroll
                        for (int bj = 0; bj < 2; ++bj) {
                            const f32x4 v0 = acc[ai][bj][m][0], v1 = acc[ai][bj][m][1];
                            st16((void*)(bd + (size_t)(2 * bj) * hstride), pack8(v0, v1));
                            if (fd) { st16f((void*)(fd + bj * HALF), v0); st16f((void*)(fd + bj * HALF + 4), v1); }
                        }
                    }
            } else {
                bf16_t* base = (bf16_t*)(r1 + (kind == 0 ? ER_GA : kind == 1 ? ER_QB : ER_GB));
#pragma unroll
                for (int ai = 0; ai < 2; ++ai)
#pragma unroll
                    for (int m = 0; m < 4; ++m) {
                        const int row = rowb + ai * HALF + m * 16;
                        bf16_t* bd = base + (size_t)row * 512 + colt;
#pragma unroll
                        for (int bj = 0; bj < 2; ++bj) {
                            f32x4 v0 = acc[ai][bj][m][0], v1 = acc[ai][bj][m][1];
                            if (kind == 1) { v0 = v0 * EP_C2; v1 = v1 * EP_C2; } else { v0 = silu4(v0); v1 = silu4(v1); }
                            st16((void*)(bd + bj * HALF), pack8(v0, v1));
                        }
                    }
            }
        }
    }
};

template <class Epi, class Sched, bool ALIGN_EPI = false, bool SP2 = false>
__device__ __forceinline__ void gemm_phase(PG8_LAS unsigned char* lds, const Gemm g, const Sched& S, const Epi& E) {
    const int tid = threadIdx.x, wid = __builtin_amdgcn_readfirstlane(tid >> 6), lane = tid & 63, wr = wid >> 2, wc = wid & 3, fr = lane & 15, fq = lane >> 4;
    const int K = g.K, nt = K / BK;
    unsigned voffA[2], voffB[2];
#pragma unroll
    for (int i = 0; i < 2; ++i) { int R, C; stage_rc(tid * 16 + i * 8192, R, C); const int Rb = Epi::PERM ? ((R & ~31) + perm32(R & 31)) : R;
        voffA[i] = (unsigned)(R * g.a_ld + C) * 2u; voffB[i] = (unsigned)(Rb * K + C) * 2u; }
    const size_t kstep = (size_t)(BK * 2);
    const size_t hstep = (size_t)HALF * K * 2;
    const size_t tstep = 2 * hstep;
    const size_t kstepA = g.a_kstep, hstepA = (size_t)HALF * g.a_ld * 2, tstepA = 2 * hstepA;
    const unsigned ldsw = (unsigned)wid * 1024u;
    const int aoff = lds_byte(wr * 64 + fr, fq * 8), boff = lds_byte(wc * 32 + fr, fq * 8);
#define PG8_SA(b, h) (((b) * 2 + (h)) * HTB)
#define PG8_SB(b, h) ((4 + (b) * 2 + (h)) * HTB)
#define PG8_STAGE(bufoff, gbase, voff) do { _Pragma("unroll") for (int _i = 0; _i < 2; ++_i) \
        __builtin_amdgcn_global_load_lds((const unsigned*)((const char*)(gbase) + (voff)[_i]), (PG8_LAS unsigned*)(lds + (bufoff) + ldsw + _i * 8192), 16, 0, 0); } while (0)
#define PG8_LDA(dst, b, h) do { _Pragma("unroll") for (int m = 0; m < 4; ++m) _Pragma("unroll") for (int k = 0; k < 2; ++k) dst[m][k] = *(const PG8_LAS bf16x8*)(lds + PG8_SA(b, h) + aoff + m * 2048 + k * 1024); } while (0)
#define PG8_LDB(dst, b, h) do { _Pragma("unroll") for (int n = 0; n < 2; ++n) _Pragma("unroll") for (int k = 0; k < 2; ++k) dst[n][k] = *(const PG8_LAS bf16x8*)(lds + PG8_SB(b, h) + boff + n * 2048 + k * 1024); } while (0)
#define PG8_MMA(ai, bj, At, Bt) do { __builtin_amdgcn_s_setprio(1); _Pragma("unroll") for (int m = 0; m < 4; ++m) _Pragma("unroll") for (int n = 0; n < 2; ++n) _Pragma("unroll") for (int k = 0; k < 2; ++k) \
        acc[ai][bj][m][n] = __builtin_amdgcn_mfma_f32_16x16x32_bf16(Bt[n][k], At[m][k], acc[ai][bj][m][n], 0, 0, 0); __builtin_amdgcn_s_setprio(0); } while (0)
#define PG8_WAIT_V(n) asm volatile("s_waitcnt vmcnt(" #n ")" ::: "memory")
#define PG8_WAIT_L(n) asm volatile("s_waitcnt lgkmcnt(" #n ")" ::: "memory")
#define PG8_BAR __builtin_amdgcn_s_barrier()
#define PG8_SCHED __builtin_amdgcn_sched_barrier(0)
    Unit cur, nxt; int ui = 0;
    if (!S.next(0, cur)) return;
    f32x4 acc[2][2][4][2];
#pragma unroll
    for (int a = 0; a < 2; ++a)
#pragma unroll
        for (int b = 0; b < 2; ++b)
#pragma unroll
            for (int m = 0; m < 4; ++m)
#pragma unroll
                for (int n = 0; n < 2; ++n) acc[a][b][m][n] = (f32x4){0.f, 0.f, 0.f, 0.f};
    bf16x8 At[4][2], B0[2][2], B1[2][2];
    const char* cA = (const char*)g.A + (size_t)cur.pm * tstepA; const char* cB = (const char*)g.Bt + (size_t)cur.pn * tstep;
    S.a_ready(cur);
    if constexpr (SP2) {
        PG8_STAGE(PG8_SB(0, 0), cB, voffB); PG8_STAGE(PG8_SB(0, 1), cB + hstep, voffB); PG8_STAGE(PG8_SA(0, 0), cA, voffA); PG8_STAGE(PG8_SA(0, 1), cA + hstepA, voffA);
        if (wr == 1) PG8_BAR;
        PG8_WAIT_V(2); PG8_BAR;
        PG8_STAGE(PG8_SB(1, 0), cB + kstep, voffB); PG8_STAGE(PG8_SA(1, 0), cA + kstepA, voffA); PG8_STAGE(PG8_SB(1, 1), cB + hstep + kstep, voffB);
        PG8_WAIT_V(6); PG8_BAR;
    } else {
        PG8_STAGE(PG8_SB(0, 0), cB, voffB); PG8_STAGE(PG8_SA(0, 0), cA, voffA); PG8_STAGE(PG8_SB(0, 1), cB + hstep, voffB); PG8_STAGE(PG8_SA(0, 1), cA + hstepA, voffA);
        if (wr == 1) PG8_BAR;
        PG8_WAIT_V(4); PG8_BAR;
        PG8_STAGE(PG8_SB(1, 0), cB + kstep, voffB); PG8_STAGE(PG8_SA(1, 0), cA + kstepA, voffA); PG8_STAGE(PG8_SB(1, 1), cB + hstep + kstep, voffB);
        PG8_WAIT_V(6); PG8_BAR;
    }
    for (;;) {
        const bool has_next = S.next(ui + 1, nxt);
        const char* nA = has_next ? (const char*)g.A + (size_t)nxt.pm * tstepA : cA; const char* nB = has_next ? (const char*)g.Bt + (size_t)nxt.pn * tstep : cB;
        for (int t = 0; t < nt; t += 2) {
            const bool last = (t == nt - 2);
            const char* a1 = cA + (size_t)(t + 1) * kstepA;
            const char* a2 = last ? nA : cA + (size_t)(t + 2) * kstepA; const char* b2 = last ? nB : cB + (size_t)(t + 2) * kstep;
            const char* a3 = a2 + kstepA; const char* b3 = b2 + kstep;
            if (last && has_next) S.a_ready(nxt);
            if constexpr (SP2) {
            PG8_LDB(B0, 0, 0); PG8_LDB(B1, 0, 1); PG8_SCHED; PG8_LDA(At, 0, 0); PG8_STAGE(PG8_SA(1, 1), a1 + hstepA, voffA);
            PG8_WAIT_V(8); PG8_WAIT_L(0); PG8_BAR; PG8_MMA(0, 0, At, B0); PG8_MMA(0, 1, At, B1); PG8_BAR; PG8_SCHED;
            PG8_LDA(At, 0, 1); PG8_STAGE(PG8_SB(0, 0), b2, voffB); PG8_STAGE(PG8_SB(0, 1), b2 + hstep, voffB); PG8_STAGE(PG8_SA(0, 0), a2, voffA);
            PG8_WAIT_V(8); PG8_WAIT_L(0); PG8_BAR; PG8_MMA(1, 0, At, B0); PG8_MMA(1, 1, At, B1); PG8_BAR; PG8_SCHED;
            PG8_LDB(B0, 1, 0); PG8_LDB(B1, 1, 1); PG8_SCHED; PG8_LDA(At, 1, 0); PG8_STAGE(PG8_SA(0, 1), a2 + hstepA, voffA);
            PG8_WAIT_V(8); PG8_WAIT_L(0); PG8_BAR; PG8_MMA(0, 0, At, B0); PG8_MMA(0, 1, At, B1); PG8_BAR; PG8_SCHED;
            PG8_LDA(At, 1, 1); PG8_STAGE(PG8_SB(1, 0), b3, voffB); PG8_STAGE(PG8_SB(1, 1), b3 + hstep, voffB); PG8_STAGE(PG8_SA(1, 0), a3, voffA);
            PG8_WAIT_V(8); PG8_WAIT_L(0); PG8_BAR; PG8_MMA(1, 0, At, B0); PG8_MMA(1, 1, At, B1); PG8_BAR; PG8_SCHED;
            } else {
            PG8_LDB(B0, 0, 0); PG8_SCHED; PG8_LDA(At, 0, 0); PG8_STAGE(PG8_SA(1, 1), a1 + hstepA, voffA);
            PG8_WAIT_L(8); PG8_BAR; PG8_WAIT_L(0); PG8_MMA(0, 0, At, B0); PG8_BAR; PG8_SCHED;
            PG8_LDB(B1, 0, 1); PG8_STAGE(PG8_SB(0, 0), b2, voffB);
            PG8_BAR; PG8_WAIT_L(0); PG8_MMA(0, 1, At, B1); PG8_BAR;
            PG8_LDA(At, 0, 1); PG8_STAGE(PG8_SA(0, 0), a2, voffA);
            PG8_BAR; PG8_WAIT_L(0); PG8_MMA(1, 0, At, B0); PG8_BAR; PG8_SCHED;
            PG8_STAGE(PG8_SB(0, 1), b2 + hstep, voffB);
            PG8_WAIT_V(6); PG8_BAR; PG8_MMA(1, 1, At, B1); PG8_BAR;
            PG8_LDB(B0, 1, 0); PG8_SCHED; PG8_LDA(At, 1, 0); PG8_STAGE(PG8_SA(0, 1), a2 + hstepA, voffA);
            PG8_WAIT_L(8); PG8_BAR; PG8_WAIT_L(0); PG8_MMA(0, 0, At, B0); PG8_BAR; PG8_SCHED;
            PG8_LDB(B1, 1, 1); PG8_STAGE(PG8_SB(1, 0), b3, voffB);
            PG8_BAR; PG8_WAIT_L(0); PG8_MMA(0, 1, At, B1); PG8_BAR;
            PG8_LDA(At, 1, 1); PG8_STAGE(PG8_SA(1, 0), a3, voffA);
            PG8_BAR; PG8_WAIT_L(0); PG8_MMA(1, 0, At, B0); PG8_BAR; PG8_SCHED;
            PG8_STAGE(PG8_SB(1, 1), b3 + hstep, voffB);
            PG8_WAIT_V(6); PG8_BAR; PG8_MMA(1, 1, At, B1); PG8_BAR;
            }
        }
        if constexpr (ALIGN_EPI) { if (wr == 0) PG8_BAR; }
        if constexpr (!Epi::AFTER_DRAIN) { E(acc, cur, wr, wc, fr, fq); S.done(cur); }
        if (!has_next) break;
#pragma unroll
        for (int a = 0; a < 2; ++a)
#pragma unroll
            for (int b = 0; b < 2; ++b)
#pragma unroll
                for (int m = 0; m < 4; ++m)
#pragma unroll
                    for (int n = 0; n < 2; ++n) acc[a][b][m][n] = (f32x4){0.f, 0.f, 0.f, 0.f};
        cur = nxt; cA = nA; cB = nB; ++ui;
        if constexpr (ALIGN_EPI) { if (wr == 1) PG8_BAR; }
    }
    PG8_WAIT_V(0);
    if constexpr (!ALIGN_EPI) { if (wr == 0) PG8_BAR; }
    PG8_BAR;
    if constexpr (Epi::AFTER_DRAIN) { E.fused(acc, cur, wr, wc, fr, fq, lds, wid, lane); S.done(cur); }
#undef PG8_SA
#undef PG8_SB
#undef PG8_STAGE
#undef PG8_LDA
#undef PG8_LDB
#undef PG8_MMA
#undef PG8_WAIT_V
#undef PG8_WAIT_L
#undef PG8_BAR
#undef PG8_SCHED
}
}
#define GAS __attribute__((address_space(1)))
#define LAS __attribute__((address_space(3)))
typedef unsigned short bf16;
typedef unsigned v4u __attribute__((ext_vector_type(4)));
typedef float f32x4 __attribute__((ext_vector_type(4)));
typedef short bf16x8 __attribute__((ext_vector_type(8)));
typedef GAS unsigned gu32;
typedef GAS unsigned long long gu64;
#define RLX_AGENT __ATOMIC_RELAXED, __HIP_MEMORY_SCOPE_AGENT
#define LDS_WAIT() asm volatile("s_waitcnt lgkmcnt(0)" ::: "memory")
#define VM_WAIT() asm volatile("s_waitcnt vmcnt(0)" ::: "memory")
__device__ __forceinline__ unsigned long long rt() { return __builtin_amdgcn_s_memrealtime(); }
__device__ __forceinline__ unsigned f2bf(float f) { unsigned u = __builtin_bit_cast(unsigned, f); return (u + 0x7fffu + ((u >> 16) & 1u)) >> 16; }
__device__ __forceinline__ unsigned pk2(float lo, float hi) { return f2bf(lo) | (f2bf(hi) << 16); }
__device__ __forceinline__ void st_wt8(void* p, unsigned long long v) { __hip_atomic_store((unsigned long long*)p, v, __ATOMIC_RELAXED, __HIP_MEMORY_SCOPE_AGENT); }
__device__ __forceinline__ void st_wt16(void* p, v4u v) { asm volatile("global_store_dwordx4 %0, %1, off sc0 sc1\n\ts_nop 1" :: "v"(p), "v"(v) : "memory"); }
__device__ __forceinline__ void st_wt16f(void* p, f32x4 v) { asm volatile("global_store_dwordx4 %0, %1, off sc0 sc1\n\ts_nop 1" :: "v"(p), "v"(v) : "memory"); }

#define XB_TMO      128
#define XB_XCNT(j)  (256  + 64 * (j))
#define XB_XSUB(j)  (1280 + 64 * (j))
#define XB_XGEN(j)  (2304 + 64 * (j))
#define XB_TOP      3328
#define XB_TOPGEN   3392
#define XCD_BAR_WORDS 3456
#define XB_SPIN_CAP (1u << 18)

__device__ __forceinline__ unsigned xb_ld(unsigned* p)              { return __hip_atomic_load(p, __ATOMIC_RELAXED, __HIP_MEMORY_SCOPE_AGENT); }
__device__ __forceinline__ unsigned xb_add(unsigned* p, unsigned v) { return __hip_atomic_fetch_add(p, v, __ATOMIC_RELAXED, __HIP_MEMORY_SCOPE_AGENT); }
__device__ __forceinline__ unsigned xb_xcc_id() { return (unsigned)__builtin_amdgcn_s_getreg((3 << 11) | 20) & 0xFu; }
#define XB_SPIN(cond, bar) do { unsigned _sp = 0; while (cond) { __builtin_amdgcn_s_sleep(1); \
    if ((++_sp & 255u) == 0u) { if (xb_ld(&(bar)[XB_TMO])) break; if (_sp > XB_SPIN_CAP) { atomicAdd(&(bar)[XB_TMO], 1u); break; } } } } while (0)

struct XcdBarrier {
    unsigned* bar; unsigned x;
    volatile LAS unsigned* st;
};

__device__ __forceinline__ XcdBarrier xcd_barrier_post(unsigned* bar, volatile LAS unsigned* st) {
    XcdBarrier b; b.bar = bar; b.x = xb_xcc_id(); b.st = st;
    if (threadIdx.x == 0) (void)xb_add(&bar[XB_XCNT(b.x)], 1u);
    return b;
}
__device__ __forceinline__ void xcd_barrier_complete(unsigned* bar, unsigned x, unsigned& nloc, unsigned& nx) {
    const unsigned G = gridDim.x * gridDim.y * gridDim.z;
    unsigned sum, cnt, mine, sp = 0u;
    for (;;) {
        sum = 0u; cnt = 0u; mine = 0u;
#pragma unroll
        for (unsigned j = 0; j < 16; ++j) { const unsigned c = xb_ld(&bar[XB_XCNT(j)]); sum += c; cnt += (c > 0u) ? 1u : 0u; mine = (j == x) ? c : mine; }
        if (sum == G) break;
        __builtin_amdgcn_s_sleep(1);
        if ((++sp & 255u) == 0u) { if (xb_ld(&bar[XB_TMO])) break; if (sp > XB_SPIN_CAP) { atomicAdd(&bar[XB_TMO], 1u); break; } }
    }
    nloc = mine > 0u ? mine : 1u; nx = cnt > 0u ? cnt : 1u;
}

__device__ __forceinline__ void xcd_barrier(const XcdBarrier& b) {
    asm volatile("s_waitcnt vmcnt(0)" ::: "memory");
    __syncthreads();
    if (threadIdx.x == 0) {
        unsigned* bar = b.bar;
        __builtin_amdgcn_s_waitcnt(0);
        unsigned nloc = b.st[0], nx = b.st[1];
        if (nloc == 0u) { xcd_barrier_complete(bar, b.x, nloc, nx); b.st[0] = nloc; b.st[1] = nx; }
        const unsigned old = xb_add(&bar[XB_XSUB(b.x)], 1u);
        const unsigned gen = old / nloc;
        if (old + 1u == (gen + 1u) * nloc) {
            __builtin_amdgcn_fence(__ATOMIC_RELEASE, "agent");
            asm volatile("s_waitcnt vmcnt(0)" ::: "memory");
            const unsigned og = xb_add(&bar[XB_TOP], 1u);
            const unsigned tg = og / nx;
            if (og + 1u == (tg + 1u) * nx) xb_add(&bar[XB_TOPGEN], 1u);
            else XB_SPIN(xb_ld(&bar[XB_TOPGEN]) == tg, bar);
            __builtin_amdgcn_fence(__ATOMIC_ACQUIRE, "agent");
            xb_add(&bar[XB_XGEN(b.x)], 1u);
            asm volatile("s_waitcnt vmcnt(0)" ::: "memory");
        } else {
            XB_SPIN(xb_ld(&bar[XB_XGEN(b.x)]) == gen, bar);
            __builtin_amdgcn_fence(__ATOMIC_ACQUIRE, "agent");
            asm volatile("s_waitcnt vmcnt(0)" ::: "memory");
        }
    }
    __syncthreads();
}

constexpr int NWAVES = 8;
constexpr int DM = 1024, BATCH = 16, SEQ = 2048, DEC_B = 32, DEC_T = 32, PAST = 1024;
constexpr int MP = BATCH * SEQ, MS = DEC_B * DEC_T, M = MP + MS;
constexpr int NIN = 3328;
constexpr float EPS = 1e-6f, LOG2E = 1.4426950408889634f;
constexpr size_t O_Y = 0, O_AKP = 34603008, O_AVP = 34865152, O_BKP = 35127296, O_BVP = 39321600, O_CHP = 43515904, O_CCP = 43532288,
                 O_AKS = 43581440, O_AVS = 44105728, O_BKS = 44630016, O_BVS = 53018624, O_CHS = 61407232, O_CCS = 61440000, O_END = 61538304;
static_assert(O_AKP == (size_t)M * DM && O_AKP == pg8::EO_AKP && O_AVP == pg8::EO_AVP && O_BKP == pg8::EO_BKP && O_BVP == pg8::EO_BVP && O_AKS == pg8::EO_AKS && O_AVS == pg8::EO_AVS && O_BKS == pg8::EO_BKS && O_BVS == pg8::EO_BVS, "d_out map");

constexpr size_t MiB = 1u << 20;
constexpr size_t WS_CTL = 0, CTL_ZERO_BYTES = 1 * MiB;
constexpr size_t WS_WIN0 = 1 * MiB;
constexpr size_t WS_WOUT0 = 8 * MiB;
constexpr size_t WS_WIN1 = 10 * MiB;
constexpr size_t WS_WOUT1 = 14 * MiB;
constexpr size_t WS_ROPE = 16 * MiB;
constexpr size_t WS_XN = 17 * MiB;
constexpr size_t WS_MIX = 84 * MiB;
constexpr size_t WS_R1 = 151 * MiB;
constexpr size_t SZ512 = (size_t)M * 512 * 2;
constexpr size_t SZ_TA = (size_t)16 * 2 * 64 * 4096, SZ_TB = (size_t)16 * 8 * 64 * 4096, SZ_SA = (size_t)32 * 2 * 5 * 4096, SZ_SB = (size_t)32 * 8 * 17 * 4096;
constexpr size_t R_QA = 0, R_GA = R_QA + SZ512, R_QB = R_GA + SZ512, R_GB = R_QB + SZ512, R_KTA = R_GB + SZ512, R_VTA = R_KTA + SZ_TA, R_KTB = R_VTA + SZ_TA, R_VTB = R_KTB + SZ_TB,
                 R_KSA = R_VTB + SZ_TB, R_VSA = R_KSA + SZ_SA, R_KSB = R_VSA + SZ_SA, R_VSB = R_KSB + SZ_SB, R_END = R_VSB + SZ_SB;
static_assert(R_END <= 256 * MiB && R_QA == pg8::ER_QA && R_GA == pg8::ER_GA && R_QB == pg8::ER_QB && R_GB == pg8::ER_GB && R_KTA == pg8::ER_KTA && R_VTA == pg8::ER_VTA && R_KTB == pg8::ER_KTB && R_VTB == pg8::ER_VTB && R_KSA == pg8::ER_KSA && R_VSA == pg8::ER_VSA && R_KSB == pg8::ER_KSB && R_VSB == pg8::ER_VSB, "R1 region");
constexpr size_t R_M1 = 0;
constexpr size_t R_XB = 0, R_ZB = (size_t)M * 1024 * 2;
constexpr size_t WS_END = WS_R1 + 256 * MiB;
constexpr int CW_BAR = 4096;
constexpr int CW_GEMMQ = 1024;
constexpr int CW_ATTNQ = 512;

constexpr int RING_OFF = 0, RING_BYTES = 131072;
constexpr int LDSCTL_OFF = RING_BYTES, MISC_OFF = LDSCTL_OFF + 320;
constexpr int LDS_BYTES = 147456;
static_assert(MISC_OFF + 128 <= LDS_BYTES, "LDS map");

struct Args { const float* in[23]; float* out; unsigned char* ws; int ph_lo, ph_hi; };
static_assert(sizeof(Args) == 23 * 8 + 8 + 8 + 8, "Args has no padding");
struct Frame {
    LAS unsigned char* lds;
    volatile LAS unsigned* MISC;
    gu32* ctl;
    int tid, lane, wave;
    int vcu, G;
};
typedef const __attribute__((address_space(4))) Args* CArgs;
__device__ __forceinline__ CArgs kargs() { auto p = __builtin_amdgcn_kernarg_segment_ptr(); asm volatile("" : "+s"(p)); return (CArgs)p; }
#define A_IN(k) (A->in[k])
#define A_XP A_IN(0)
#define A_XS A_IN(1)
#define A_CAK A_IN(2)
#define A_CAV A_IN(3)
#define A_CBK A_IN(4)
#define A_CBV A_IN(5)
#define A_STH A_IN(6)
#define A_STCONV A_IN(7)
#define A_LNPRE A_IN(8)
#define A_LNPOST A_IN(9)
#define A_WIN0 A_IN(10)
#define A_SINKS A_IN(11)
#define A_RELPOS A_IN(12)
#define A_WOUT0 A_IN(13)
#define A_WIN1 A_IN(14)
#define A_CONVW A_IN(15)
#define A_CONVB A_IN(16)
#define A_GWA A_IN(17)
#define A_GBA A_IN(18)
#define A_GWX A_IN(19)
#define A_GBX A_IN(20)
#define A_LAM A_IN(21)
#define A_WOUT1 A_IN(22)
#define W_BF(off) ((bf16*)(A->ws + (off)))
#define W_WIN0T W_BF(WS_WIN0)
#define W_WOUT0T W_BF(WS_WOUT0)
#define W_WIN1T W_BF(WS_WIN1)
#define W_WOUT1T W_BF(WS_WOUT1)
#define W_ROPE ((float*)(A->ws + WS_ROPE))
#define W_XN W_BF(WS_XN)
#define W_MIX W_BF(WS_MIX)
#define W_QA W_BF(WS_R1 + R_QA)
#define W_GA W_BF(WS_R1 + R_GA)
#define W_QB W_BF(WS_R1 + R_QB)
#define W_GB W_BF(WS_R1 + R_GB)
#define W_KTA (A->ws + WS_R1 + R_KTA)
#define W_VTA (A->ws + WS_R1 + R_VTA)
#define W_KTB (A->ws + WS_R1 + R_KTB)
#define W_VTB (A->ws + WS_R1 + R_VTB)
#define W_KSA (A->ws + WS_R1 + R_KSA)
#define W_VSA (A->ws + WS_R1 + R_VSA)
#define W_KSB (A->ws + WS_R1 + R_KSB)
#define W_VSB (A->ws + WS_R1 + R_VSB)
#define W_M1 W_BF(WS_R1 + R_M1)
#define W_XB W_BF(WS_R1 + R_XB)
#define W_ZB W_BF(WS_R1 + R_ZB)
__device__ __forceinline__ const float* x_row(CArgs A, int m) { return m < MP ? A_XP + (size_t)m * DM : A_XS + (size_t)(m - MP) * DM; }

__device__ __forceinline__ float wave_sum(float v) {
#pragma unroll
    for (int o = 1; o < 64; o <<= 1) v += __shfl_xor(v, o);
    return v;
}
__device__ __forceinline__ float bf2f(unsigned short b) { return __uint_as_float((unsigned)b << 16); }
__device__ __forceinline__ float bflo(unsigned w) { return __uint_as_float(w << 16); }
__device__ __forceinline__ float bfhi(unsigned w) { return __uint_as_float(w & 0xffff0000u); }

__host__ __device__ __forceinline__ int rope_perm_col(int d) { const int n = d >> 5, w = (d >> 4) & 1, fq = (d >> 2) & 3, j = d & 3; return 32 * w + 8 * fq + 4 * n + j; }
__host__ __device__ __forceinline__ int win0_row(int n) { return n < 640 ? (n & ~63) + rope_perm_col(n & 63) : n; }

template <int MAP>
__device__ __forceinline__ void p0_transpose_item(const float* W, int K, int N, bf16* WT, LAS float* scr, int item, int lane, const float* gk = nullptr) {
    const int nblk = N / 32, kb = item / nblk, nb = item % nblk, k0 = 64 * kb, n0 = 32 * nb;
#pragma unroll 8
    for (int i = 0; i < 32; ++i) { const int kk = 2 * i + (lane >> 5); float v = W[(size_t)(k0 + kk) * N + n0 + (lane & 31)]; if (gk) v *= gk[k0 + kk]; scr[kk * 33 + (lane & 31)] = v; }
    LDS_WAIT(); asm volatile("" ::: "memory");
    const int c = lane & 7;
#pragma unroll
    for (int j = 0; j < 4; ++j) { const int n = (lane >> 3) + 8 * j; const LAS float* s = scr + (8 * c) * 33 + n;
        v4u o; o.x = pk2(s[0 * 33], s[1 * 33]); o.y = pk2(s[2 * 33], s[3 * 33]); o.z = pk2(s[4 * 33], s[5 * 33]); o.w = pk2(s[6 * 33], s[7 * 33]);
        const int drow = MAP ? win0_row(n0 + n) : (n0 + n);
        st_wt16((void*)(WT + (size_t)drow * K + k0 + 8 * c), o); }
    LDS_WAIT(); asm volatile("" ::: "memory");
}
__device__ __forceinline__ void rms_row_to_bf16(int lane, const float* xrow, const float* g, bf16* orow) {
    const GAS f32x4* xr = (const GAS f32x4*)xrow + lane; const GAS f32x4* gr = (const GAS f32x4*)g + lane;
    f32x4 v[4]; float s = 0.f;
#pragma unroll
    for (int j = 0; j < 4; ++j) { v[j] = xr[64 * j]; s += (v[j].x * v[j].x + v[j].y * v[j].y) + (v[j].z * v[j].z + v[j].w * v[j].w); }
    const float rstd = 1.0f / sqrtf(wave_sum(s) * (1.f / DM) + EPS);
    GAS unsigned long long* o8 = (GAS unsigned long long*)orow + lane;
#pragma unroll
    for (int j = 0; j < 4; ++j) { const f32x4 gg = gr[64 * j]; const f32x4 y = v[j] * rstd * gg; o8[64 * j] = (unsigned long long)pk2(y.x, y.y) | ((unsigned long long)pk2(y.z, y.w) << 32); }
}
__constant__ float kRopeInv[32] = {0x1.0000000000000p+0f, 0x1.7ff2240000000p-1f, 0x1.1feb340000000p-1f, 0x1.afd1360000000p-2f, 0x1.43d1360000000p-2f, 0x1.e5a8480000000p-3f, 0x1.6c310e0000000p-3f, 0x1.111aec0000000p-3f,
    0x1.99999a0000000p-4f, 0x1.33281a0000000p-4f, 0x1.ccab860000000p-5f, 0x1.59742c0000000p-5f, 0x1.030dc40000000p-5f, 0x1.8486a00000000p-6f, 0x1.235a720000000p-6f, 0x1.b4f7e40000000p-7f,
    0x1.47ae140000000p-7f, 0x1.eb735e0000000p-8f, 0x1.7089380000000p-8f, 0x1.145cee0000000p-8f, 0x1.9e7c6e0000000p-9f, 0x1.36d2180000000p-9f, 0x1.d22a500000000p-10f, 0x1.5d931c0000000p-10f,
    0x1.0624de0000000p-10f, 0x1.89291a0000000p-11f, 0x1.26d42c0000000p-11f, 0x1.ba2e4c0000000p-12f, 0x1.4b96be0000000p-12f, 0x1.f150280000000p-13f, 0x1.74eea60000000p-13f, 0x1.17a8e40000000p-13f};
__device__ __forceinline__ void sincos_acc(float angf, float& c, float& s) {
    const double a = (double)angf; const double k = __builtin_rint(a * 0.63661977236758134308);
    const double r = __builtin_fma(-k, 6.123233995736766e-17, __builtin_fma(-k, 1.5707963267948966, a));
    const double r2 = r * r;
    double sp = -1.0 / 1307674368000.0; sp = sp * r2 + 1.0 / 6227020800.0; sp = sp * r2 - 1.0 / 39916800.0; sp = sp * r2 + 1.0 / 362880.0; sp = sp * r2 - 1.0 / 5040.0; sp = sp * r2 + 1.0 / 120.0; sp = sp * r2 - 1.0 / 6.0; sp = sp * r2 + 1.0;
    const double sr = sp * r;
    double cp = 1.0 / 20922789888000.0; cp = cp * r2 - 1.0 / 87178291200.0; cp = cp * r2 + 1.0 / 479001600.0; cp = cp * r2 - 1.0 / 3628800.0; cp = cp * r2 + 1.0 / 40320.0; cp = cp * r2 - 1.0 / 720.0; cp = cp * r2 + 1.0 / 24.0; cp = cp * r2 - 0.5; cp = cp * r2 + 1.0;
    const int q = ((int)k) & 3;
    const double cc = (q == 0) ? cp : (q == 1) ? -sr : (q == 2) ? -cp : sr;
    const double ss = (q == 0) ? sr : (q == 1) ? cp : (q == 2) ? -sr : -cp;
    c = (float)cc; s = (float)ss;
}

__device__ __forceinline__ void p0_prologue(Frame& F, CArgs A) {
    LAS float* scr = (LAS float*)(F.lds + RING_OFF + F.wave * 16384);
    const int gw = F.vcu * NWAVES + F.wave, NGW = F.G * NWAVES;
    constexpr int I_0 = (DM / 64) * (NIN / 32), I_1 = (DM / 64) * (DM / 32), I_2 = (DM / 64) * (2 * DM / 32), I_3 = I_1;
    constexpr int NITEMS = I_0 + I_1 + I_2 + I_3;
    for (int it = gw; it < NITEMS; it += NGW) {
        int r = it;
        if (r < I_0) { p0_transpose_item<1>(A_WIN0, DM, NIN, W_WIN0T, scr, r, F.lane); continue; } r -= I_0;
        if (r < I_1) { p0_transpose_item<0>(A_WOUT0, DM, DM, W_WOUT0T, scr, r, F.lane); continue; } r -= I_1;
        if (r < I_2) { p0_transpose_item<0>(A_WIN1, DM, 2 * DM, W_WIN1T, scr, r, F.lane, A_LNPRE + DM); continue; } r -= I_2;
        p0_transpose_item<0>(A_WOUT1, DM, DM, W_WOUT1T, scr, r, F.lane);
    }
    {
        const int lane = F.lane; const int r0 = (int)(((long)gw * M) / NGW), r1 = (int)(((long)(gw + 1) * M) / NGW);
        f32x4 g[4];
#pragma unroll
        for (int j = 0; j < 4; ++j) g[j] = ((const GAS f32x4*)A_LNPRE + lane)[64 * j];
        for (int rb = r0; rb < r1; rb += 4) {
            const int nr = r1 - rb < 4 ? r1 - rb : 4; f32x4 v[4][4];
#pragma unroll
            for (int q = 0; q < 4; ++q) if (q < nr) { const GAS f32x4* xr = (const GAS f32x4*)x_row(A, rb + q) + lane;
#pragma unroll
                for (int j = 0; j < 4; ++j) v[q][j] = xr[64 * j]; }
#pragma unroll
            for (int q = 0; q < 4; ++q) if (q < nr) { float ss = 0.f;
#pragma unroll
                for (int j = 0; j < 4; ++j) ss += (v[q][j].x * v[q][j].x + v[q][j].y * v[q][j].y) + (v[q][j].z * v[q][j].z + v[q][j].w * v[q][j].w);
                const float rstd = 1.0f / sqrtf(wave_sum(ss) * (1.f / DM) + EPS);
                GAS unsigned long long* o8 = (GAS unsigned long long*)(W_XN + (size_t)(rb + q) * DM) + lane;
#pragma unroll
                for (int j = 0; j < 4; ++j) { const f32x4 y = v[q][j] * rstd * g[j]; st_wt8((void*)(o8 + 64 * j), (unsigned long long)pk2(y.x, y.y) | ((unsigned long long)pk2(y.z, y.w) << 32)); } }
        }
    }
    const int gt = gw * 64 + F.lane, NGT = NGW * 64;
    for (int i = gt; i < 2048 * 32; i += NGT) { const int pos = i >> 5, k = i & 31; const float ang = (float)pos * kRopeInv[k]; float c, s; sincos_acc(ang, c, s); W_ROPE[pos * 64 + k] = c; W_ROPE[pos * 64 + 32 + k] = s; }
    for (int i = gt; i < 32 * 128 * 128 / 4; i += NGT) {
        const int e = i * 4, b = e >> 14, r = (e >> 7) & 127, col = e & 127, kvh = col >> 6, d = col & 63;
        const f32x4 k4 = *(const GAS f32x4*)(A_CAK + e), v4 = *(const GAS f32x4*)(A_CAV + e);
        const size_t tb = (size_t)((b * 2 + kvh) * 5 + (r >> 5)) * 4096; const int key = r & 31;
        st_wt8((void*)(W_KSA + tb + (d >> 3) * 512 + key * 16 + (d & 7) * 2), (unsigned long long)pk2(k4.x, k4.y) | ((unsigned long long)pk2(k4.z, k4.w) << 32));
        st_wt8((void*)(W_VSA + tb + (d >> 5) * 2048 + key * 64 + (d & 31) * 2), (unsigned long long)pk2(v4.x, v4.y) | ((unsigned long long)pk2(v4.z, v4.w) << 32));
        if (r >= 32) { const size_t fo = (size_t)(b * 128 + r - 32) * 128 + col; st_wt16f((void*)(A->out + O_AKS + fo), k4); st_wt16f((void*)(A->out + O_AVS + fo), v4); }
    }
    for (int i = gt; i < 32 * 512 * 512 / 4; i += NGT) {
        const int e = i * 4, b = e >> 18, r = (e >> 9) & 511, col = e & 511, h = col >> 6, d = col & 63;
        const f32x4 k4 = *(const GAS f32x4*)(A_CBK + e), v4 = *(const GAS f32x4*)(A_CBV + e);
        const size_t tb = (size_t)((b * 8 + h) * 17 + (r >> 5)) * 4096; const int key = r & 31;
        st_wt8((void*)(W_KSB + tb + (d >> 3) * 512 + key * 16 + (d & 7) * 2), (unsigned long long)pk2(k4.x, k4.y) | ((unsigned long long)pk2(k4.z, k4.w) << 32));
        st_wt8((void*)(W_VSB + tb + (d >> 5) * 2048 + key * 64 + (d & 31) * 2), (unsigned long long)pk2(v4.x, v4.y) | ((unsigned long long)pk2(v4.z, v4.w) << 32));
        if (r >= 32) { const size_t fo = (size_t)(b * 512 + r - 32) * 512 + col; st_wt16f((void*)(A->out + O_BKS + fo), k4); st_wt16f((void*)(A->out + O_BVS + fo), v4); }
    }
}

typedef float f32x16 __attribute__((ext_vector_type(16)));
typedef short s16x4 __attribute__((ext_vector_type(4)));
typedef short v4i16_t __attribute__((ext_vector_type(4)));
typedef float f32x2_t __attribute__((ext_vector_type(2))); typedef __bf16 bf16x2_t __attribute__((ext_vector_type(2)));
__device__ __forceinline__ unsigned cvtpk_s(float lo, float hi) { f32x2_t v = {lo, hi}; bf16x2_t b = __builtin_convertvector(v, bf16x2_t); return __builtin_bit_cast(unsigned, b); }
__device__ __forceinline__ s16x4 vtr(const LAS unsigned char* p) { return __builtin_bit_cast(s16x4, __builtin_amdgcn_ds_read_tr16_b64_v4i16((LAS v4i16_t*)p)); }
__device__ __forceinline__ float swap_max(float v) { auto rr = __builtin_amdgcn_permlane32_swap(__float_as_uint(v), __float_as_uint(v), false, false); return fmaxf(__uint_as_float(rr[0]), __uint_as_float(rr[1])); }
__device__ __forceinline__ float swap_add(float v) { auto rr = __builtin_amdgcn_permlane32_swap(__float_as_uint(v), __float_as_uint(v), false, false); return __uint_as_float(rr[0]) + __uint_as_float(rr[1]); }
__constant__ unsigned char kAttnTab[16][8] = {{0x8, 0x18, 0x2f, 0x3f, 0xff, 0xff, 0xff, 0xff}, {0x9, 0x19, 0x30, 0x1, 0xff, 0xff, 0xff, 0xff}, {0xa, 0x1a, 0x31, 0x21, 0xff, 0xff, 0xff, 0xff}, {0xb, 0x1b, 0x32, 0x60, 0xff, 0xff, 0xff, 0xff},
    {0xc, 0x1c, 0x33, 0x61, 0xff, 0xff, 0xff, 0xff}, {0xd, 0x1d, 0x34, 0x0, 0xff, 0xff, 0xff, 0xff}, {0xe, 0x1e, 0x35, 0x20, 0xff, 0xff, 0xff, 0xff}, {0xf, 0x1f, 0x36, 0xff, 0xff, 0xff, 0xff, 0xff},
    {0x10, 0x7, 0x2b, 0x3b, 0xff, 0xff, 0xff, 0xff}, {0x11, 0x6, 0x29, 0x39, 0xff, 0xff, 0xff, 0xff}, {0x12, 0x5, 0x27, 0x37, 0xff, 0xff, 0xff, 0xff}, {0x13, 0x4, 0x26, 0x2e, 0x3e, 0xff, 0xff, 0xff},
    {0x14, 0x40, 0x24, 0x2c, 0x3c, 0xff, 0xff, 0xff}, {0x15, 0x41, 0x25, 0x2d, 0x3d, 0xff, 0xff, 0xff}, {0x16, 0x3, 0x23, 0x2a, 0x3a, 0xff, 0xff, 0xff}, {0x17, 0x2, 0x22, 0x28, 0x38, 0xff, 0xff, 0xff}};
__device__ __forceinline__ void glds16x4(const void* gsrc, unsigned lds_dst) { unsigned keep;
    asm volatile("s_mov_b32 %0, m0\n\ts_mov_b32 m0, %2\n\ts_nop 0\n\tglobal_load_lds_dwordx4 %1, off\n\tglobal_load_lds_dwordx4 %1, off offset:1024\n\tglobal_load_lds_dwordx4 %1, off offset:2048\n\tglobal_load_lds_dwordx4 %1, off offset:3072\n\ts_mov_b32 m0, %0"
                 : "=&s"(keep) : "v"(gsrc), "s"(lds_dst) : "memory"); }
constexpr int BTAB_OFF = 132096;
static_assert(BTAB_OFF >= MISC_OFF + 128 && BTAB_OFF + 8 * 260 * 4 <= LDS_BYTES, "bias table in LDS");
__device__ __forceinline__ float max3f(float a, float b, float c) { float r; asm("v_max3_f32 %0, %1, %2, %3" : "=v"(r) : "v"(a), "v"(b), "v"(c)); return r; }
__device__ __forceinline__ float rowmax16(const f32x16& S) {
    float a = max3f(S[0], S[1], S[2]), b = max3f(S[3], S[4], S[5]); a = max3f(a, S[6], S[7]); b = max3f(b, S[8], S[9]); a = max3f(a, S[10], S[11]); b = max3f(b, S[12], S[13]); a = max3f(a, S[14], S[15]);
    return swap_max(fmaxf(a, b));
}
__device__ __forceinline__ void attn_block_step(const bf16x8 (&qr)[4], f32x16& o0, f32x16& o1, f32x16& lacc, float& mref, bool first, bool biased, int i0, const LAS float* bt,
                                                const bf16x8 (&kc)[4], const bf16x8 (&vf)[4]) {
    constexpr float THR = 8.0f;
    f32x16 S;
#pragma unroll
    for (int r = 0; r < 16; ++r) S[r] = -mref;
#pragma unroll
    for (int d0 = 0; d0 < 4; ++d0) S = __builtin_amdgcn_mfma_f32_32x32x16_bf16(kc[d0], qr[d0], S, 0, 0, 0);
    if (biased) {
#pragma unroll
        for (int r = 0; r < 16; ++r) { int ix = i0 - ((r & 3) + 8 * (r >> 2)); ix = ix < 0 ? 0 : (ix > 256 ? 256 : ix); S[r] += bt[ix]; }
    }
    float mx = rowmax16(S);
    if (first) {
        mref = mx;
#pragma unroll
        for (int r = 0; r < 16; ++r) S[r] -= mx;
    } else if (__any(mx > THR)) {
        const float dl = fmaxf(mx, 0.f), alpha = __builtin_amdgcn_exp2f(-dl); mref += dl;
#pragma unroll
        for (int r = 0; r < 16; ++r) { S[r] -= dl; o0[r] *= alpha; o1[r] *= alpha; lacc[r] *= alpha; }
    }
#pragma unroll
    for (int r = 0; r < 16; ++r) S[r] = __builtin_amdgcn_exp2f(S[r]);
    v4u pw0, pw1;
    pw0.x = cvtpk_s(S[0], S[1]); pw0.y = cvtpk_s(S[2], S[3]); pw0.z = cvtpk_s(S[4], S[5]); pw0.w = cvtpk_s(S[6], S[7]);
    pw1.x = cvtpk_s(S[8], S[9]); pw1.y = cvtpk_s(S[10], S[11]); pw1.z = cvtpk_s(S[12], S[13]); pw1.w = cvtpk_s(S[14], S[15]);
    const bf16x8 pb0 = __builtin_bit_cast(bf16x8, pw0), pb1 = __builtin_bit_cast(bf16x8, pw1);
    const bf16x8 ones = (bf16x8){(short)0x3F80, (short)0x3F80, (short)0x3F80, (short)0x3F80, (short)0x3F80, (short)0x3F80, (short)0x3F80, (short)0x3F80};
    lacc = __builtin_amdgcn_mfma_f32_32x32x16_bf16(ones, pb0, lacc, 0, 0, 0);
    lacc = __builtin_amdgcn_mfma_f32_32x32x16_bf16(ones, pb1, lacc, 0, 0, 0);
    o0 = __builtin_amdgcn_mfma_f32_32x32x16_bf16(vf[0], pb0, o0, 0, 0, 0);
    o0 = __builtin_amdgcn_mfma_f32_32x32x16_bf16(vf[1], pb1, o0, 0, 0, 0);
    o1 = __builtin_amdgcn_mfma_f32_32x32x16_bf16(vf[2], pb0, o1, 0, 0, 0);
    o1 = __builtin_amdgcn_mfma_f32_32x32x16_bf16(vf[3], pb1, o1, 0, 0, 0);
}
__device__ __forceinline__ void attn_block_out(const f32x16& o0, const f32x16& o1, const f32x16& lacc, float mref, bool isB, float sk, const bf16* grow, bf16* mrow, LAS unsigned char* stg, int lane) {
    float l = lacc[0]; float oscale;
    if (!isB) { const float mf = fmaxf(mref, sk), sc = __builtin_amdgcn_exp2f(mref - mf); l = l * sc + __builtin_amdgcn_exp2f(sk - mf); oscale = sc / l; }
    else oscale = 1.0f / l;
    const int q32 = lane & 31, hi = lane >> 5;
    LAS unsigned char* wp = stg + q32 * 144 + 8 * hi;
#pragma unroll
    for (int g = 0; g < 4; ++g) {
        *(LAS unsigned long long*)(wp + 16 * g) = (unsigned long long)cvtpk_s(o0[4 * g] * oscale, o0[4 * g + 1] * oscale) | ((unsigned long long)cvtpk_s(o0[4 * g + 2] * oscale, o0[4 * g + 3] * oscale) << 32);
        *(LAS unsigned long long*)(wp + 64 + 16 * g) = (unsigned long long)cvtpk_s(o1[4 * g] * oscale, o1[4 * g + 1] * oscale) | ((unsigned long long)cvtpk_s(o1[4 * g + 2] * oscale, o1[4 * g + 3] * oscale) << 32);
    }
    const int rr = lane >> 3, ch = lane & 7;
    v4u gv[4];
#pragma unroll
    for (int i = 0; i < 4; ++i) gv[i] = *(const GAS v4u*)(grow + (size_t)(8 * i + rr) * 512 + 8 * ch);
    LDS_WAIT(); asm volatile("" ::: "memory");
#pragma unroll
    for (int i = 0; i < 4; ++i) { const v4u ov = *(const LAS v4u*)(stg + (8 * i + rr) * 144 + 16 * ch); v4u r;
        r.x = cvtpk_s(bflo(ov.x) * bflo(gv[i].x), bfhi(ov.x) * bfhi(gv[i].x)); r.y = cvtpk_s(bflo(ov.y) * bflo(gv[i].y), bfhi(ov.y) * bfhi(gv[i].y));
        r.z = cvtpk_s(bflo(ov.z) * bflo(gv[i].z), bfhi(ov.z) * bfhi(gv[i].z)); r.w = cvtpk_s(bflo(ov.w) * bflo(gv[i].w), bfhi(ov.w) * bfhi(gv[i].w));
        st_wt16((void*)(mrow + (size_t)(8 * i + rr) * 1024 + 8 * ch), r); }
}
__device__ __forceinline__ void attn_mfma_phase(Frame& F, CArgs A) {
    const int lane0 = F.lane; const int gw = F.vcu * NWAVES + F.wave, NGW = F.G * NWAVES;
    LAS unsigned char* ring = F.lds + RING_OFF + F.wave * 16384;
    const unsigned ring_a = (unsigned)(uintptr_t)ring;
    LAS float* btab = (LAS float*)(F.lds + BTAB_OFF);
    for (int i = F.tid; i < 8 * 257; i += NWAVES * 64) { const int hh = i / 257; btab[hh * 260 + (i - hh * 257)] = (A_RELPOS[i] - A_RELPOS[hh * 257 + 256]) * LOG2E; }
    __syncthreads();
    unsigned* qctr = (unsigned*)(F.ctl + CW_ATTNQ + 64 * ((int)blockIdx.x & 7));
    int ticket = gw;
    {
        while (ticket < 8704) {
            int lane = lane0; asm volatile("" : "+v"(lane));
            const unsigned nxt = lane0 == 0 ? __hip_atomic_fetch_add(qctr, 1u, __ATOMIC_RELAXED, __HIP_MEMORY_SCOPE_AGENT) : 0u;
            bool isB, sample; int b, h, c, bs;
            if (ticket < 4096) { isB = true; sample = false; c = 31 - (ticket >> 7); b = (ticket >> 3) & 15; h = ticket & 7; bs = 0; }
            else if (ticket < 4352) { const int t2 = ticket - 4096; isB = true; sample = true; c = 0; b = 0; bs = t2 >> 3; h = t2 & 7; }
            else if (ticket < 8448) { const int t2 = ticket - 4352; isB = false; sample = false; c = 31 - (t2 >> 7); b = (t2 >> 3) & 15; h = t2 & 7; bs = 0; }
            else { const int t2 = ticket - 8448; isB = false; sample = true; c = 0; b = 0; bs = t2 >> 3; h = t2 & 7; }
            const int q32 = lane & 31, hi = lane >> 5;
            const size_t qrow0 = (sample ? (size_t)(MP + bs * 32) : (size_t)(b * 2048 + c * 64)) + q32;
            const bf16* qp = (isB ? W_QB : W_QA) + qrow0 * 512 + h * 64 + hi * 8;
            const unsigned char *kt, *vt; int st_lo, st_hi, kpos0;
            if (!sample) {
                if (isB) { const size_t o = (size_t)((b * 8 + h) * 64) * 4096; kt = W_KTB + o; vt = W_VTB + o; st_lo = (c - 8) * 2; }
                else { const size_t o = (size_t)((b * 2 + (h >> 2)) * 64) * 4096; kt = W_KTA + o; vt = W_VTA + o; st_lo = (c - 2) * 2; }
                if (st_lo < 0) st_lo = 0; st_hi = (c + 1) * 2; kpos0 = 0;
            } else {
                if (isB) { const size_t o = (size_t)((bs * 8 + h) * 17) * 4096; kt = W_KSB + o; vt = W_VSB + o; st_hi = 17; kpos0 = 512; }
                else { const size_t o = (size_t)((bs * 2 + (h >> 2)) * 5) * 4096; kt = W_KSA + o; vt = W_VSA + o; st_hi = 5; kpos0 = 896; }
                st_lo = 0;
            }
#define ATT_DMA(st_, so_) do { const unsigned char* kp_ = kt + (size_t)(st_) * 4096 + lane * 16; const unsigned char* vp_ = vt + (size_t)(st_) * 4096 + lane * 16; \
                const unsigned d_ = (unsigned)__builtin_amdgcn_readfirstlane((int)(ring_a + (so_))); \
                glds16x4(kp_, d_); glds16x4(vp_, d_ + 4096); } while (0)
            const int nst = st_hi - st_lo; int off = (nst - (st_lo % nst)) % nst;
            int off1 = off + 1 == nst ? 0 : off + 1;
            ATT_DMA(st_lo + off, 0);
            if (nst > 1) ATT_DMA(st_lo + off1, 8192);
            bf16x8 qa[4], qb[4];
#pragma unroll
            for (int d0 = 0; d0 < 4; ++d0) { qa[d0] = *(const GAS bf16x8*)(qp + d0 * 16); qb[d0] = *(const GAS bf16x8*)(qp + (sample ? 0 : 32 * 512) + d0 * 16); }
            const int qbase = sample ? PAST : c * 64;
            const LAS float* bt = btab + h * 260;
            float mra = 0.f, mrb = 0.f; f32x16 oa0, oa1, la, ob0, ob1, lb;
#pragma unroll
            for (int r = 0; r < 16; ++r) { oa0[r] = 0.f; oa1[r] = 0.f; la[r] = 0.f; ob0[r] = 0.f; ob1[r] = 0.f; lb[r] = 0.f; }
            const int vlane = 4096 + ((lane >> 4) & 1) * 32 + (lane & 3) * 8 + (4 * hi + ((lane & 15) >> 2)) * 64;
            for (int i = 0; i < nst; ++i) {
                const int st = st_lo + off; const int off2 = off1 + 1 == nst ? 0 : off1 + 1;
                const int cur = (i & 1) * 8192;
                if (i + 1 < nst) asm volatile("s_waitcnt vmcnt(8)" ::: "memory");
                else asm volatile("s_waitcnt vmcnt(0)" ::: "memory");
                bf16x8 kc[4], vf[4];
                { const LAS unsigned char* kb = ring + cur + lane * 16;
#pragma unroll
                  for (int d0 = 0; d0 < 4; ++d0) kc[d0] = *(const LAS bf16x8*)(kb + d0 * 1024);
                  const LAS unsigned char* vb = ring + cur + vlane;
#pragma unroll
                  for (int j = 0; j < 4; ++j) { const s16x4 x0 = vtr(vb + j * 1024), x1 = vtr(vb + j * 1024 + 512); vf[j] = (bf16x8){x0[0], x0[1], x0[2], x0[3], x1[0], x1[1], x1[2], x1[3]}; } }
                if (i + 2 < nst) {
                    asm volatile("s_waitcnt lgkmcnt(0)" : "+v"(kc[0]), "+v"(kc[1]), "+v"(kc[2]), "+v"(kc[3]), "+v"(vf[0]), "+v"(vf[1]), "+v"(vf[2]), "+v"(vf[3]) :: "memory");
                    ATT_DMA(st_lo + off2, cur);
                }
                off = off1; off1 = off2;
                const int kbase = kpos0 + st * 32; const bool first = i == 0;
                const int i0 = qbase + q32 - kbase - 4 * hi + 128;
                attn_block_step(qa, oa0, oa1, la, mra, first, isB && (qbase - kbase - 31 < 128), i0, bt, kc, vf);
                if (!sample) attn_block_step(qb, ob0, ob1, lb, mrb, first, isB && (qbase + 32 - kbase - 31 < 128), i0 + 32, bt, kc, vf);
            }
#undef ATT_DMA
            const int ticket_next = NGW + 8 * (int)__builtin_amdgcn_readfirstlane((int)nxt) + ((int)blockIdx.x & 7);
            const float sk = isB ? 0.f : A_SINKS[h] * LOG2E;
            const size_t qr0 = qrow0 - q32;
            const bf16* gp = (isB ? W_GB : W_GA) + qr0 * 512 + h * 64; bf16* mp = W_MIX + qr0 * 1024 + (isB ? 512 : 0) + h * 64;
            asm volatile("s_waitcnt lgkmcnt(0)" ::: "memory");
            attn_block_out(oa0, oa1, la, mra, isB, sk, gp, mp, ring, lane);
            if (!sample) attn_block_out(ob0, ob1, lb, mrb, isB, sk, gp + 32 * 512, mp + 32 * 1024, ring + 4608, lane);
            LDS_WAIT(); asm volatile("" ::: "memory");
            ticket = ticket_next;
        }
    }
}

#define W_RS2 ((float*)(A->ws + WS_ROPE + 512 * 1024))
template <int LAYER>
__device__ __forceinline__ void rowpass_phase(Frame& F, CArgs A) {
    int lane = F.lane; asm volatile("" : "+v"(lane));
    const int gw = F.vcu * NWAVES + F.wave, NGW = F.G * NWAVES;
    const int r0 = (int)(((long)gw * M) / NGW), r1 = (int)(((long)(gw + 1) * M) / NGW);
    const GAS f32x4* gp = (const GAS f32x4*)(A_LNPOST + LAYER * DM) + lane;
    f32x4 g[4];
#pragma unroll
    for (int j = 0; j < 4; ++j) g[j] = gp[64 * j];
    for (int rb = r0; rb < r1; rb += 4) {
        const int nr = r1 - rb < 4 ? r1 - rb : 4;
        unsigned long long mw[4][4]; f32x4 bs[4][4]; unsigned long long bw[4][4];
#pragma unroll
        for (int q = 0; q < 4; ++q) if (q < nr) { const int m = rb + q;
            const GAS unsigned long long* mr = (const GAS unsigned long long*)(W_M1 + (size_t)m * DM) + lane;
#pragma unroll
            for (int j = 0; j < 4; ++j) mw[q][j] = mr[64 * j];
            if (LAYER == 0) { const GAS f32x4* br = (const GAS f32x4*)x_row(A, m) + lane;
#pragma unroll
                for (int j = 0; j < 4; ++j) bs[q][j] = br[64 * j]; }
            else { const GAS unsigned long long* br = (const GAS unsigned long long*)(W_XN + (size_t)m * DM) + lane;
#pragma unroll
                for (int j = 0; j < 4; ++j) bw[q][j] = br[64 * j]; } }
#pragma unroll
        for (int q = 0; q < 4; ++q) if (q < nr) { const int m = rb + q;
            f32x4 v[4]; float ss = 0.f;
#pragma unroll
            for (int j = 0; j < 4; ++j) { const unsigned lo = (unsigned)mw[q][j], hi = (unsigned)(mw[q][j] >> 32); v[j] = (f32x4){bflo(lo), bfhi(lo), bflo(hi), bfhi(hi)};
                ss += (v[j].x * v[j].x + v[j].y * v[j].y) + (v[j].z * v[j].z + v[j].w * v[j].w); }
            const float rstd = 1.0f / sqrtf(wave_sum(ss) * (1.f / DM) + EPS);
            if (LAYER == 0) {
                float s2 = 0.f; GAS unsigned long long* o8 = (GAS unsigned long long*)(W_XN + (size_t)m * DM) + lane;
#pragma unroll
                for (int j = 0; j < 4; ++j) { const f32x4 y = bs[q][j] + v[j] * rstd * g[j]; s2 += (y.x * y.x + y.y * y.y) + (y.z * y.z + y.w * y.w);
                    st_wt8((void*)(o8 + 64 * j), (unsigned long long)pk2(y.x, y.y) | ((unsigned long long)pk2(y.z, y.w) << 32)); }
                s2 = wave_sum(s2);
                if (lane == 0) W_RS2[m] = 1.0f / sqrtf(s2 * (1.f / DM) + EPS);
            } else {
                GAS f32x4* yo = (GAS f32x4*)(A->out + (size_t)m * DM) + lane;
#pragma unroll
                for (int j = 0; j < 4; ++j) { const unsigned lo = (unsigned)bw[q][j], hi = (unsigned)(bw[q][j] >> 32); const f32x4 y1 = (f32x4){bflo(lo), bfhi(lo), bflo(hi), bfhi(hi)};
                    st_wt16f((void*)(yo + 64 * j), y1 + v[j] * rstd * g[j]); }
            } }
    }
}

__device__ __forceinline__ float sigmoid_fast(float v) { return __builtin_amdgcn_rcpf(1.0f + __builtin_amdgcn_exp2f(-LOG2E * v)); }
__device__ __forceinline__ void lru_phase(Frame& F, CArgs A) {
    int lane = F.lane; asm volatile("" : "+v"(lane)); const int w = F.wave; const int c16 = lane & 15, fq = lane >> 4;
    LAS float* xcs = (LAS float*)(F.lds + RING_OFF) + w * 3072;
    LAS float* as_ = xcs + 1024; LAS float* us_ = xcs + 2048;
    LAS float* segs = (LAS float*)(F.lds + RING_OFF + 98304);
    for (int unit = blockIdx.x; unit < 768; unit += F.G) {
        const bool sample = unit >= 256; const int uu = sample ? unit - 256 : unit; const int b = uu >> 4, n = uu & 15;
        const int T = sample ? DEC_T : SEQ; const int m0 = sample ? MP + b * DEC_T : b * SEQ; const int ch = n * 64 + lane;
        bf16x8 wf[8][2];
#pragma unroll
        for (int nn = 0; nn < 8; ++nn)
#pragma unroll
            for (int ks = 0; ks < 2; ++ks) { const float* src = (nn < 4 ? A_GWA : A_GWX) + (size_t)n * 4096 + (size_t)(32 * ks + 8 * fq) * 64 + 16 * (nn & 3) + c16;
                v4u pw; pw.x = pk2(src[0], src[64]); pw.y = pk2(src[128], src[192]); pw.z = pk2(src[256], src[320]); pw.w = pk2(src[384], src[448]); wf[nn][ks] = __builtin_bit_cast(bf16x8, pw); }
        float bav[4], bxv[4], c8v[4];
#pragma unroll
        for (int nn = 0; nn < 4; ++nn) { const int cg = n * 64 + 16 * nn + c16; bav[nn] = A_GBA[cg]; bxv[nn] = A_GBX[cg]; c8v[nn] = -8.0f * LOG2E * log1pf(expf(-A_LAM[cg])); }
        const float cb = A_CONVB[ch];
        const float cw0 = A_CONVW[ch], cw1 = A_CONVW[DM + ch], cw2 = A_CONVW[2 * DM + ch], cw3 = A_CONVW[3 * DM + ch];
        float hcar = sample ? A_STH[(size_t)b * DM + ch] : 0.f;
        const int ntile = (T + 127) / 128;
        const size_t rb = ((size_t)n * M + m0 + w * 16) * 64 + lane;
        const bf16* xp = W_XB + rb; const bf16* zp = W_ZB + rb; bf16* yp = W_MIX + rb;
        const bool act0 = w * 16 < T;
        float xv[16], zv[16], xm3 = 0.f, xm2 = 0.f, xm1 = 0.f;
#pragma unroll
        for (int tk = 0; tk < 16; ++tk) { xv[tk] = 0.f; zv[tk] = 0.f; }
        if (act0) {
#pragma unroll
            for (int tk = 0; tk < 16; ++tk) { xv[tk] = bf2f(xp[tk * 64]); zv[tk] = bf2f(zp[tk * 64]); }
            if (w > 0) { xm3 = bf2f(xp[-3 * 64]); xm2 = bf2f(xp[-2 * 64]); xm1 = bf2f(xp[-64]); }
            else if (sample) { xm3 = A_STCONV[(size_t)(b * 3 + 0) * DM + ch]; xm2 = A_STCONV[(size_t)(b * 3 + 1) * DM + ch]; xm1 = A_STCONV[(size_t)(b * 3 + 2) * DM + ch]; }
        }
        for (int tile = 0; tile < ntile; ++tile) {
            const int t0 = tile * 128 + w * 16; const bool act = t0 < T; const bool has_next = tile + 1 < ntile;
            float Aseg = 1.f, H = 0.f;
            if (act) {
#pragma unroll
                for (int tk = 0; tk < 16; ++tk) { xcs[tk * 64 + lane] = cb + cw0 * xm3 + cw1 * xm2 + cw2 * xm1 + cw3 * xv[tk]; xm3 = xm2; xm2 = xm1; xm1 = xv[tk]; }
                if (t0 + 16 == T) { float* cc = A->out + (sample ? O_CCS : O_CCP) + (size_t)(b * 3) * DM + ch; cc[0] = xm3; cc[DM] = xm2; cc[2 * DM] = xm1; }
                if (has_next) {
                    const bf16* xn = xp + (size_t)(tile + 1) * 128 * 64;
                    xm3 = bf2f(xn[-3 * 64]); xm2 = bf2f(xn[-2 * 64]); xm1 = bf2f(xn[-64]);
#pragma unroll
                    for (int tk = 0; tk < 16; ++tk) xv[tk] = bf2f(xn[tk * 64]);
                }
                LDS_WAIT(); asm volatile("" ::: "memory");
                bf16x8 af[2];
#pragma unroll
                for (int ks = 0; ks < 2; ++ks) { const LAS f32x4* xr = (const LAS f32x4*)(xcs + c16 * 64 + 32 * ks + 8 * fq); const f32x4 x0 = xr[0], x1 = xr[1];
                    v4u pw; pw.x = cvtpk_s(x0.x, x0.y); pw.y = cvtpk_s(x0.z, x0.w); pw.z = cvtpk_s(x1.x, x1.y); pw.w = cvtpk_s(x1.z, x1.w); af[ks] = __builtin_bit_cast(bf16x8, pw); }
                f32x4 acc[8];
#pragma unroll
                for (int nn = 0; nn < 8; ++nn) { const float bb = nn < 4 ? bav[nn & 3] : bxv[nn & 3]; acc[nn] = (f32x4){bb, bb, bb, bb};
                    acc[nn] = __builtin_amdgcn_mfma_f32_16x16x32_bf16(af[0], wf[nn][0], acc[nn], 0, 0, 0); acc[nn] = __builtin_amdgcn_mfma_f32_16x16x32_bf16(af[1], wf[nn][1], acc[nn], 0, 0, 0); }
#pragma unroll
                for (int nn = 0; nn < 4; ++nn)
#pragma unroll
                    for (int e = 0; e < 4; ++e) { const int o = (4 * fq + e) * 64 + 16 * nn + c16;
                        const float r = sigmoid_fast(acc[nn][e]), gi = sigmoid_fast(acc[nn + 4][e]); const float av = __builtin_amdgcn_exp2f(c8v[nn] * r);
                        as_[o] = av; us_[o] = __builtin_amdgcn_sqrtf(fmaxf(1.0f - av * av, 0.f)) * (gi * xcs[o]); }
                LDS_WAIT(); asm volatile("" ::: "memory");
#pragma unroll
                for (int tk = 0; tk < 16; ++tk) { const float av = as_[tk * 64 + lane]; H = av * H + us_[tk * 64 + lane]; Aseg *= av; }
            }
            LAS float* sg = segs + (tile & 1) * 1024;
            sg[w * 128 + lane] = Aseg; sg[w * 128 + 64 + lane] = H;
            LDS_WAIT(); __syncthreads();
            float hin = hcar, hall = hcar;
#pragma unroll
            for (int ww = 0; ww < 8; ++ww) { const float Aw = sg[ww * 128 + lane], Hw = sg[ww * 128 + 64 + lane]; hall = Aw * hall + Hw; if (ww < w) hin = Aw * hin + Hw; }
            hcar = hall;
            if (act) {
                float h = hin; bf16* yo = yp + (size_t)tile * 128 * 64;
#pragma unroll
                for (int tk = 0; tk < 16; ++tk) { h = as_[tk * 64 + lane] * h + us_[tk * 64 + lane]; yo[tk * 64] = (bf16)(cvtpk_s(h * zv[tk], 0.f) & 0xffffu); }
                if (has_next) { const bf16* zn = zp + (size_t)(tile + 1) * 128 * 64;
#pragma unroll
                    for (int tk = 0; tk < 16; ++tk) zv[tk] = bf2f(zn[tk * 64]); }
            }
        }
        if (w == 0) A->out[(sample ? O_CHS : O_CHP) + (size_t)b * DM + ch] = hcar;
        __syncthreads();
    }
}

template <int MODE>
__device__ __forceinline__ void mini_gemm_sample(Frame& F, const bf16* Ab, int a_ld, size_t a_kstep, const bf16* Bt, int N, bf16* O0, bf16* O1, const float* rs) {
    int lane = F.lane; asm volatile("" : "+v"(lane)); const int w = F.wave, fr = lane & 15, fq = lane >> 4;
    LAS float* part = (LAS float*)(F.lds + RING_OFF);
    const int ntn = N / 64;
    for (int jj = blockIdx.x / 8; jj < 2 * ntn; jj += F.G / 8) {
        const int tm = 2 * (blockIdx.x % 8) + jj / ntn, tn = jj % ntn; const int r0 = MP + 64 * tm, c0 = 64 * tn;
        f32x4 acc[4][4];
#pragma unroll
        for (int mi = 0; mi < 4; ++mi)
#pragma unroll
            for (int ni = 0; ni < 4; ++ni) acc[mi][ni] = (f32x4){0.f, 0.f, 0.f, 0.f};
#pragma unroll
        for (int kp = 0; kp < 2; ++kp) {
            const int k = 128 * w + 64 * kp + 8 * fq;
            const bf16* ap = Ab + (size_t)(k >> 6) * (a_kstep / 2) + (size_t)(r0 + fr) * a_ld + (k & 63);
            const bf16* bp = Bt + (size_t)(c0 + fr) * 1024 + k;
            bf16x8 af[2][4], bfm[2][4];
#pragma unroll
            for (int i = 0; i < 4; ++i) { af[0][i] = *(const GAS bf16x8*)(ap + (size_t)(16 * i) * a_ld); af[1][i] = *(const GAS bf16x8*)(ap + (size_t)(16 * i) * a_ld + 32);
                bfm[0][i] = *(const GAS bf16x8*)(bp + (size_t)(16 * i) * 1024); bfm[1][i] = *(const GAS bf16x8*)(bp + (size_t)(16 * i) * 1024 + 32); }
#pragma unroll
            for (int h2 = 0; h2 < 2; ++h2)
#pragma unroll
                for (int mi = 0; mi < 4; ++mi)
#pragma unroll
                    for (int ni = 0; ni < 4; ++ni) acc[mi][ni] = __builtin_amdgcn_mfma_f32_16x16x32_bf16(bfm[h2][ni], af[h2][mi], acc[mi][ni], 0, 0, 0);
        }
        __syncthreads();
#pragma unroll
        for (int mi = 0; mi < 4; ++mi)
#pragma unroll
            for (int ni = 0; ni < 4; ++ni) *(LAS f32x4*)(part + (size_t)w * 4096 + (16 * mi + fr) * 64 + (((4 * ni + fq) ^ (fr & 7)) << 2)) = acc[mi][ni];
        LDS_WAIT(); __syncthreads();
        const int rr = 8 * w + (lane >> 3), cc = 8 * (lane & 7);
        f32x4 s0 = (f32x4){0.f, 0.f, 0.f, 0.f}, s1 = s0;
#pragma unroll
        for (int pw = 0; pw < 8; ++pw) { const LAS float* pr = part + (size_t)pw * 4096 + rr * 64; const int c4 = cc >> 2;
            s0 = s0 + *(const LAS f32x4*)(pr + ((c4 ^ (rr & 7)) << 2)); s1 = s1 + *(const LAS f32x4*)(pr + (((c4 + 1) ^ (rr & 7)) << 2)); }
        const int row = r0 + rr;
        if (MODE == 0) { st_wt16((void*)(O0 + (size_t)row * 1024 + c0 + cc), __builtin_bit_cast(v4u, pg8::pack8(s0, s1))); }
        else { const float sc = rs[row]; s0 = s0 * sc; s1 = s1 * sc; const bool isz = c0 >= 1024; if (isz) { s0 = pg8::silu4(s0); s1 = pg8::silu4(s1); }
            bf16* dst = (isz ? O1 : O0) + ((size_t)((c0 & 1023) >> 6) * M + row) * 64 + cc; st_wt16((void*)dst, __builtin_bit_cast(v4u, pg8::pack8(s0, s1))); }
    }
    __syncthreads();
}

#ifndef MK_N_LAUNCHES
#define MK_N_LAUNCHES 1
#endif
constexpr int PER_PHASE = 9;
constexpr int N_LAUNCHES = MK_N_LAUNCHES;
__global__ void __launch_bounds__(NWAVES * 64, 2) hybrid_fwd(Args A_) {
    extern __shared__ __attribute__((aligned(16))) unsigned char lds[];
    Frame F;
    F.lds = (LAS unsigned char*)lds;
    F.MISC = (volatile LAS unsigned*)(F.lds + MISC_OFF);
    F.tid = threadIdx.x; F.lane = F.tid & 63; F.wave = __builtin_amdgcn_readfirstlane(F.tid >> 6);
    F.G = gridDim.x; { const int bx = blockIdx.x; F.vcu = (F.G % 8 == 0) ? (bx % 8) * (F.G / 8) + bx / 8 : bx; }
    F.ctl = (gu32*)(A_.ws + WS_CTL);
    for (int u = F.tid; u < (LDS_BYTES - LDSCTL_OFF) / 4; u += NWAVES * 64) ((LAS unsigned*)(F.lds + LDSCTL_OFF))[u] = 0u;
    __syncthreads();
    XcdBarrier bar; bar.bar = (unsigned*)(F.ctl + CW_BAR); bar.x = 0; bar.st = nullptr;
    if (N_LAUNCHES == 1) bar = xcd_barrier_post((unsigned*)(F.ctl + CW_BAR), F.MISC + 8);
#define GRID_BAR() do { if (N_LAUNCHES == 1) xcd_barrier(bar); } while (0)
    const int lo = A_.ph_lo, hi = A_.ph_hi;
#ifndef PHMASK
#define PHMASK 0x1ff
#endif
#define IN(k) (((PHMASK >> (k)) & 1) && lo <= (k) && (k) < hi)
#define BOTH(k) (IN(k) && IN((k) + 1))
#ifndef PROBE_DUP
#define PROBE_DUP (-1)
#endif
#define REP(k) for (int rep_ = 0; rep_ < ((k) == PROBE_DUP ? 2 : 1); ++rep_)

    if (IN(0)) { CArgs A = kargs(); REP(0) p0_prologue(F, A); if (BOTH(0)) GRID_BAR(); }
    if (IN(1)) { CArgs A = kargs();
        pg8::Gemm g{W_XN, W_WIN0T, M, NIN, DM, DM, 128}; pg8::DynOrder S; S.init(M, NIN, F.G, (int)blockIdx.x); S.head = (unsigned*)(F.ctl + CW_GEMMQ); S.slot = (LAS unsigned*)(F.MISC + 16);
        pg8::EpiQKV E{A->ws + WS_R1, W_ROPE, A->out};
        REP(1) pg8::gemm_phase<pg8::EpiQKV, pg8::DynOrder, false, true>(F.lds + RING_OFF, g, S, E);
        if (BOTH(1)) GRID_BAR();
    }
    if (IN(2)) { CArgs A = kargs(); REP(2) attn_mfma_phase(F, A); if (BOTH(2)) GRID_BAR(); }
    if (IN(3)) { CArgs A = kargs();
        pg8::Gemm g{W_MIX, W_WOUT0T, MP, DM, DM, DM, 128}; pg8::StaticOrder S; S.init(MP, DM, F.G, (int)blockIdx.x);
        pg8::EpiBf16 E{W_M1, DM};
        REP(3) { pg8::gemm_phase<pg8::EpiBf16, pg8::StaticOrder, false, true>(F.lds + RING_OFF, g, S, E); mini_gemm_sample<0>(F, W_MIX, DM, 128, W_WOUT0T, DM, W_M1, nullptr, nullptr); }
        if (BOTH(3)) GRID_BAR();
    }
    if (IN(4)) { CArgs A = kargs(); REP(4) rowpass_phase<0>(F, A); if (BOTH(4)) GRID_BAR(); }
    if (IN(5)) { CArgs A = kargs();
        pg8::Gemm g{W_XN, W_WIN1T, MP, 2 * DM, DM, DM, 128}; pg8::StaticOrder S; S.init(MP, 2 * DM, F.G, (int)blockIdx.x);
        pg8::EpiXZ E{W_XB, W_ZB, W_RS2};
        REP(5) { pg8::gemm_phase<pg8::EpiXZ, pg8::StaticOrder, false, true>(F.lds + RING_OFF, g, S, E); mini_gemm_sample<1>(F, W_XN, DM, 128, W_WIN1T, 2 * DM, W_XB, W_ZB, W_RS2); }
        if (BOTH(5)) GRID_BAR();
    }
    if (IN(6)) { CArgs A = kargs(); REP(6) lru_phase(F, A); if (BOTH(6)) GRID_BAR(); }
    if (IN(7)) { CArgs A = kargs();
        pg8::Gemm g{W_MIX, W_WOUT1T, MP, DM, DM, 64, (size_t)M * 128}; pg8::StaticOrder S; S.init(MP, DM, F.G, (int)blockIdx.x);
        pg8::EpiBf16 E{W_M1, DM};
        REP(7) { pg8::gemm_phase<pg8::EpiBf16, pg8::StaticOrder, false, true>(F.lds + RING_OFF, g, S, E); mini_gemm_sample<0>(F, W_MIX, 64, (size_t)M * 128, W_WOUT1T, DM, W_M1, nullptr, nullptr); }
        if (BOTH(7)) GRID_BAR();
    }
    if (IN(8)) { CArgs A = kargs(); rowpass_phase<1>(F, A); }
#undef IN
#undef BOTH
}

extern "C" void kernel_launch(void* const* d_in, const int* in_sizes, int n_in, void* d_out, int out_size, void* d_ws, size_t ws_size, hipStream_t stream) {
    static int grid = 0;
    if (grid == 0) {
        if (n_in != 23 || in_sizes[0] != MP * DM || (size_t)out_size != O_END || ws_size < WS_END) { fprintf(stderr, "kernel_launch: unexpected shapes: n_in %d in0 %d out %d ws %zu\n", n_in, n_in > 0 ? in_sizes[0] : -1, out_size, ws_size); grid = -1; return; }
        int dev = 0, cus = 0, per_cu = 0;
        if (hipGetDevice(&dev) != hipSuccess || hipDeviceGetAttribute(&cus, hipDeviceAttributeMultiprocessorCount, dev) != hipSuccess) { grid = -1; return; }
        if (hipFuncSetAttribute((const void*)hybrid_fwd, hipFuncAttributeMaxDynamicSharedMemorySize, LDS_BYTES) != hipSuccess) { fprintf(stderr, "kernel_launch: hipFuncSetAttribute failed\n"); grid = -1; return; }
        if (hipOccupancyMaxActiveBlocksPerMultiprocessor(&per_cu, (const void*)hybrid_fwd, NWAVES * 64, LDS_BYTES) != hipSuccess || per_cu < 1) fprintf(stderr, "kernel_launch: occupancy query reports %d blocks per CU\n", per_cu);
        (void)hipGetLastError();
        grid = cus - cus % 8;
    }
    if (grid < 0) return;
    if (hipMemsetAsync((char*)d_ws + WS_CTL, 0, CTL_ZERO_BYTES, stream) != hipSuccess) { fprintf(stderr, "kernel_launch: memset failed\n"); return; }
    Args a{};
    for (int i = 0; i < 23; ++i) a.in[i] = (const float*)d_in[i];
    a.out = (float*)d_out; a.ws = (unsigned char*)d_ws;
    for (int li = 0; li < N_LAUNCHES; ++li) {
        a.ph_lo = (N_LAUNCHES == 1) ? 0 : li; a.ph_hi = (N_LAUNCHES == 1) ? PER_PHASE : li + 1;
        hipLaunchKernelGGL(hybrid_fwd, dim3(grid), dim3(NWAVES * 64), LDS_BYTES, stream, a);
        const hipError_t le = hipPeekAtLastError();
        if (le != hipSuccess) { fprintf(stderr, "kernel_launch: launch %d failed: %s\n", li, hipGetErrorName(le)); break; }
    }
}
```

```cpp
#include <hip/hip_runtime.h>
#include <cstdio>
#include <cstdint>
namespace pg8 {
#define PG8_LAS __attribute__((address_space(3)))
typedef unsigned short bf16_t;
typedef short bf16x8 __attribute__((ext_vector_type(8)));
typedef float f32x4 __attribute__((ext_vector_type(4)));
typedef unsigned u32x4 __attribute__((ext_vector_type(4)));
constexpr int BM = 256, BK = 64, HALF = 128, HTB = HALF * BK * 2  , STAGE_BYTES = 8 * HTB, NXCD = 8, WGM = 8;

__host__ __device__ __forceinline__ int lds_byte(int r, int c) { const int st = (r >> 4) * 2 + (c >> 5), rr = r & 15, cc = c & 31, ob = rr * 64 + cc * 2; return st * 1024 + (ob ^ (((ob >> 9) & 1) << 5)); }
__host__ __device__ __forceinline__ void stage_rc(int b, int& R, int& C) { const int st = b / 1024, sb = b % 1024, swz = sb ^ (((sb >> 9) & 1) << 5); R = (st >> 1) * 16 + swz / 64; C = (st & 1) * 32 + (swz % 64) / 2; }
__host__ __device__ __forceinline__ int perm32(int rho) { const int n = rho >> 4, i = rho & 15; return 8 * (i >> 2) + 4 * n + (i & 3); }

struct Unit { int pm, pn; };
struct Gemm { const bf16_t* A; const bf16_t* Bt; int M, N, K; int a_ld; size_t a_kstep; };

struct StaticOrder {
    int nM, nN, nwg, G, c;
    __host__ __device__ void init(int M, int N, int G_, int c_) { nM = M / BM; nN = N / BM; nwg = nM * nN; G = G_; c = c_; }
    __host__ __device__ bool next(int i, Unit& u) const {
        const long L = (long)i * G + c; if (L >= nwg) return false;
        int wgid = (int)L; { const int q = nwg / NXCD, r = nwg % NXCD, xcd = wgid % NXCD, off = wgid / NXCD; wgid = (xcd < r ? xcd * (q + 1) : r * (q + 1) + (xcd - r) * q) + off; }
        const int nig = WGM * nN, gid = wgid / nig, fm = gid * WGM, gsz = (nM - fm) < WGM ? (nM - fm) : WGM;
        u.pm = fm + ((wgid % nig) % gsz); u.pn = (wgid % nig) / gsz; return true;
    }
    __device__ __forceinline__ void a_ready(const Unit&) const {}
    __device__ __forceinline__ void done(const Unit&) const {}
};

struct DynOrder : StaticOrder {
    unsigned* head; PG8_LAS unsigned* slot;
    __device__ __forceinline__ bool next(int i, Unit& u) const {
        unsigned k;
        if (i == 0) k = (unsigned)(c / NXCD);
        else {
            if (threadIdx.x < 64) { unsigned t = 0; if (threadIdx.x == 0) t = __hip_atomic_fetch_add(head + 64 * (c % NXCD), 1u, __ATOMIC_RELAXED, __HIP_MEMORY_SCOPE_AGENT);
                t = (unsigned)__builtin_amdgcn_readfirstlane((int)t); if (threadIdx.x == 0) *slot = t + (unsigned)(G / NXCD); asm volatile("s_waitcnt lgkmcnt(0)" ::: "memory"); }
            asm volatile("" ::: "memory"); __builtin_amdgcn_s_barrier(); asm volatile("" ::: "memory");
            k = *(volatile PG8_LAS unsigned*)slot;
        }
        const long L = (long)k * NXCD + (c % NXCD); if (L >= nwg) return false;
        int wgid = (int)L; { const int q = nwg / NXCD, r = nwg % NXCD, xcd = wgid % NXCD, off = wgid / NXCD; wgid = (xcd < r ? xcd * (q + 1) : r * (q + 1) + (xcd - r) * q) + off; }
        const int nig = WGM * nN, gid = wgid / nig, fm = gid * WGM, gsz = (nM - fm) < WGM ? (nM - fm) : WGM;
        u.pm = fm + ((wgid % nig) % gsz); u.pn = (wgid % nig) / gsz; return true;
    }
};

__device__ __forceinline__ unsigned cvt_pk_bf16(float lo, float hi) { unsigned r; asm volatile("v_cvt_pk_bf16_f32 %0, %1, %2" : "=v"(r) : "v"(lo), "v"(hi)); return r; }
typedef float f32x2 __attribute__((ext_vector_type(2)));

constexpr int EP_MP = 32768, EP_PAST = 1024, EP_M = 33792;
constexpr float EP_C2 = 0.125f * 1.4426950408889634f;
constexpr size_t ER_SZ512 = (size_t)33792 * 512 * 2, ER_TA = (size_t)16 * 2 * 64 * 4096, ER_TB = (size_t)16 * 8 * 64 * 4096, ER_SA = (size_t)32 * 2 * 5 * 4096, ER_SB = (size_t)32 * 8 * 17 * 4096;
constexpr size_t ER_QA = 0, ER_GA = ER_QA + ER_SZ512, ER_QB = ER_GA + ER_SZ512, ER_GB = ER_QB + ER_SZ512, ER_KTA = ER_GB + ER_SZ512, ER_VTA = ER_KTA + ER_TA, ER_KTB = ER_VTA + ER_TA, ER_VTB = ER_KTB + ER_TB,
                 ER_KSA = ER_VTB + ER_TB, ER_VSA = ER_KSA + ER_SA, ER_KSB = ER_VSA + ER_SA, ER_VSB = ER_KSB + ER_SB;
constexpr size_t EO_AKP = 34603008, EO_AVP = 34865152, EO_BKP = 35127296, EO_BVP = 39321600;
constexpr size_t EO_AKS = 43581440, EO_AVS = 44105728, EO_BKS = 44630016, EO_BVS = 53018624;
__device__ __forceinline__ float silu_f(float v) { return v * __builtin_amdgcn_rcpf(1.0f + __builtin_amdgcn_exp2f(-1.4426950408889634f * v)); }
__device__ __forceinline__ f32x4 silu4(f32x4 v) { return (f32x4){silu_f(v[0]), silu_f(v[1]), silu_f(v[2]), silu_f(v[3])}; }
typedef unsigned u32x2 __attribute__((ext_vector_type(2)));
__device__ __forceinline__ u32x2 pack4(f32x4 v) { u32x2 w; w.x = cvt_pk_bf16(v[0], v[1]); w.y = cvt_pk_bf16(v[2], v[3]); return w; }
__device__ __forceinline__ u32x4 pack8(f32x4 a, f32x4 b) { u32x4 w; w.x = cvt_pk_bf16(a[0], a[1]); w.y = cvt_pk_bf16(a[2], a[3]); w.z = cvt_pk_bf16(b[0], b[1]); w.w = cvt_pk_bf16(b[2], b[3]); return w; }
__device__ __forceinline__ void st16(void* p, u32x4 v) { *(u32x4*)p = v; }
__device__ __forceinline__ void st16f(void* p, f32x4 v) { *(f32x4*)p = v; }
__device__ __forceinline__ void st8(void* p, u32x2 v) { *(u32x2*)p = v; }

struct EpiF32 {
    static constexpr bool PERM = false, AFTER_DRAIN = false;
    float* C; int ldc;
    __device__ __forceinline__ void operator()(const f32x4 (&acc)[2][2][4][2], const Unit& u, int wr, int wc, int fr, int fq) const {
        const int row0 = u.pm * BM + wr * 64 + fr, col0 = u.pn * BM + wc * 32 + 4 * fq;
#pragma unroll
        for (int ai = 0; ai < 2; ++ai)
#pragma unroll
            for (int m = 0; m < 4; ++m) { float* rowp = C + (size_t)(row0 + ai * HALF + m * 16) * ldc + col0;
#pragma unroll
                for (int bj = 0; bj < 2; ++bj)
#pragma unroll
                    for (int n = 0; n < 2; ++n) *(f32x4*)(rowp + bj * HALF + n * 16) = acc[ai][bj][m][n]; }
    }
};

struct EpiXZ {
    static constexpr bool PERM = true, AFTER_DRAIN = false;
    bf16_t* XB; bf16_t* ZB; const float* rs;
    __device__ __forceinline__ void operator()(const f32x4 (&acc)[2][2][4][2], const Unit& u, int wr, int wc, int fr, int fq) const {
        const int row0 = u.pm * BM + wr * 64 + fr; const bool isz = u.pn >= 4;
        bf16_t* base = (isz ? ZB : XB) + (size_t)((u.pn & 3) * 4 + (wc >> 1)) * ((size_t)EP_M * 64) + (wc & 1) * 32 + 8 * fq;
#pragma unroll
        for (int ai = 0; ai < 2; ++ai)
#pragma unroll
            for (int m = 0; m < 4; ++m) { const int row = row0 + ai * HALF + m * 16; bf16_t* rowp = base + (size_t)row * 64;
#pragma unroll
                for (int bj = 0; bj < 2; ++bj) { f32x4 v0 = acc[ai][bj][m][0], v1 = acc[ai][bj][m][1];
                    if (isz) { v0 = silu4(v0); v1 = silu4(v1); }
                    st16((void*)(rowp + (size_t)bj * 2 * ((size_t)EP_M * 64)), pack8(v0, v1)); } }
    }
};
struct EpiBf16 {
    static constexpr bool PERM = true, AFTER_DRAIN = false;
    bf16_t* C; int ldc;
    __device__ __forceinline__ void operator()(const f32x4 (&acc)[2][2][4][2], const Unit& u, int wr, int wc, int fr, int fq) const {
        const int row0 = u.pm * BM + wr * 64 + fr, col0 = u.pn * BM + wc * 32 + 8 * fq;
#pragma unroll
        for (int ai = 0; ai < 2; ++ai)
#pragma unroll
            for (int m = 0; m < 4; ++m) { bf16_t* rowp = C + (size_t)(row0 + ai * HALF + m * 16) * ldc + col0;
#pragma unroll
                for (int bj = 0; bj < 2; ++bj) st16((void*)(rowp + bj * HALF), pack8(acc[ai][bj][m][0], acc[ai][bj][m][1])); }
    }
};

struct EpiQKV {
    static constexpr bool PERM = true, AFTER_DRAIN = false;
    unsigned char* r1;
    const float* rope;
    float* out;
    __device__ __forceinline__ void operator()(const f32x4 (&acc)[2][2][4][2], const Unit& u, int wr, int wc, int fr, int fq) const {
        const int pn = u.pn; const int rowb = u.pm * BM + wr * 64 + fr; const bool sample = u.pm >= EP_MP / BM; const int w = wc & 1;
        if (pn <= 2) {
            const int dlow = 16 * w + 4 * fq;
#pragma unroll
            for (int ai = 0; ai < 2; ++ai) {
                f32x4 csv[4], snv[4];
#pragma unroll
                for (int m = 0; m < 4; ++m) { const int row = rowb + ai * HALF + m * 16; const int pos = sample ? (EP_PAST + ((row - EP_MP) & 31)) : (row & 2047);
                    const float* rp = rope + pos * 64 + dlow; csv[m] = *(const f32x4*)rp; snv[m] = *(const f32x4*)(rp + 32); }
#pragma unroll
                for (int m = 0; m < 4; ++m) {
                    const int row = rowb + ai * HALF + m * 16;
                    const f32x4 cs = csv[m], sn = snv[m];
                    float* fA = nullptr; size_t tA; int key;
                    if (sample) { const int rs = row - EP_MP, b = rs >> 5, t = rs & 31; fA = out + (size_t)(b * 128 + 96 + t) * 128; tA = (size_t)((b * 2 + (wc >> 1)) * 5 + 4) * 4096; key = t; }
                    else { const int b = row >> 11, t = row & 2047; if (t >= 1920) fA = out + (size_t)(b * 128 + (t - 1920)) * 128; tA = (size_t)((b * 2 + (wc >> 1)) * 64 + (t >> 5)) * 4096; key = t & 31; }
#pragma unroll
                    for (int bj = 0; bj < 2; ++bj) {
                        const f32x4 x1 = acc[ai][bj][m][0], x2 = acc[ai][bj][m][1];
                        if (pn < 2) {
                            const f32x4 o1 = (x1 * cs - x2 * sn) * EP_C2, o2 = (x2 * cs + x1 * sn) * EP_C2;
                            bf16_t* d = (bf16_t*)(r1 + ER_QA) + (size_t)row * 512 + (4 * pn + 2 * bj + (wc >> 1)) * 64 + dlow;
                            st8((void*)(d), pack4(o1)); st8((void*)(d + 32), pack4(o2));
                        } else if (bj == 0) {
                            const f32x4 o1 = x1 * cs - x2 * sn, o2 = x2 * cs + x1 * sn; const int c = (wc >> 1) * 64 + dlow;
                            unsigned char* d = r1 + (sample ? ER_KSA : ER_KTA) + tA + (2 * w + (fq >> 1)) * 512 + key * 16 + (fq & 1) * 8;
                            st8((void*)(d), pack4(o1)); st8((void*)(d + 2048), pack4(o2));
                            if (fA) { float* f = fA + (sample ? EO_AKS : EO_AKP) + c; st16f((void*)(f), o1); st16f((void*)(f + 32), o2); }
                        } else {
                            const int c = wc * 32 + 8 * fq;
                            unsigned char* d = r1 + (sample ? ER_VSA : ER_VTA) + tA + w * 2048 + key * 64 + fq * 16; st16((void*)(d), pack8(x1, x2));
                            if (fA) { float* f = fA + (sample ? EO_AVS : EO_AVP) + c; st16f((void*)(f), x1); st16f((void*)(f + 4), x2); }
                        }
                    }
                }
            }
        } else {
            const int kind = (pn - 3) >> 1;
            const int colt = ((pn - 3) & 1) * BM + wc * 32 + 8 * fq;
            if (kind == 2 || kind == 3) {
                unsigned char* pbase = r1 + (kind == 2 ? ER_KTB : ER_VTB); unsigned char* sbase = r1 + (kind == 2 ? ER_KSB : ER_VSB);
                const size_t fo_p = kind == 2 ? EO_BKP : EO_BVP, fo_s = kind == 2 ? EO_BKS : EO_BVS;
                const int inoff = kind == 2 ? (4 * w + fq) * 512 : w * 2048 + fq * 16; const int kmul = kind == 2 ? 16 : 64;
#pragma unroll
                for (int ai = 0; ai < 2; ++ai)
#pragma unroll
                    for (int m = 0; m < 4; ++m) {
                        const int row = rowb + ai * HALF + m * 16; float* fd = nullptr; unsigned char* bd; int hstride;
                        const int h0 = ((pn - 3) & 1) * 4 + (wc >> 1);
                        if (sample) { const int rs = row - EP_MP, b = rs >> 5, t = rs & 31; fd = out + fo_s + (size_t)(b * 512 + 480 + t) * 512 + colt;
                            bd = sbase + (size_t)((b * 8 + h0) * 17 + 16) * 4096 + inoff + t * kmul; hstride = 17 * 4096; }
                        else { const int b = row >> 11, t = row & 2047; if (t >= 1536) fd = out + fo_p + (size_t)(b * 512 + (t - 1536)) * 512 + colt;
                            bd = pbase + (size_t)((b * 8 + h0) * 64 + (t >> 5)) * 4096 + inoff + (t & 31) * kmul; hstride = 64 * 4096; }
#pragma unroll
                        for (int bj = 0; bj < 2; ++bj) {
                            const f32x4 v0 = acc[ai][bj][m][0], v1 = acc[ai][bj][m][1];
                            st16((void*)(bd + (size_t)(2 * bj) * hstride), pack8(v0, v1));
                            if (fd) { st16f((void*)(fd + bj * HALF), v0); st16f((void*)(fd + bj * HALF + 4), v1); }
                        }
                    }
            } else {
                bf16_t* base = (bf16_t*)(r1 + (kind == 0 ? ER_GA : kind == 1 ? ER_QB : ER_GB));
#pragma unroll
                for (int ai = 0; ai < 2; ++ai)
#pragma unroll
                    for (int m = 0; m < 4; ++m) {
                        const int row = rowb + ai * HALF + m * 16;
                        bf16_t* bd = base + (size_t)row * 512 + colt;
#pragma unroll
                        for (int bj = 0; bj < 2; ++bj) {
                            f32x4 v0 = acc[ai][bj][m][0], v1 = acc[ai][bj][m][1];
                            if (kind == 1) { v0 = v0 * EP_C2; v1 = v1 * EP_C2; } else { v0 = silu4(v0); v1 = silu4(v1); }
                            st16((void*)(bd + bj * HALF), pack8(v0, v1));
                        }
                    }
            }
        }
    }
};

template <class Epi, class Sched, bool ALIGN_EPI = false, bool SP2 = false>
__device__ __forceinline__ void gemm_phase(PG8_LAS unsigned char* lds, const Gemm g, const Sched& S, const Epi& E) {
    const int tid = threadIdx.x, wid = __builtin_amdgcn_readfirstlane(tid >> 6), lane = tid & 63, wr = wid >> 2, wc = wid & 3, fr = lane & 15, fq = lane >> 4;
    const int K = g.K, nt = K / BK;
    unsigned voffA[2], voffB[2];
#pragma unroll
    for (int i = 0; i < 2; ++i) { int R, C; stage_rc(tid * 16 + i * 8192, R, C); const int Rb = Epi::PERM ? ((R & ~31) + perm32(R & 31)) : R;
        voffA[i] = (unsigned)(R * g.a_ld + C) * 2u; voffB[i] = (unsigned)(Rb * K + C) * 2u; }
    const size_t kstep = (size_t)(BK * 2);
    const size_t hstep = (size_t)HALF * K * 2;
    const size_t tstep = 2 * hstep;
    const size_t kstepA = g.a_kstep, hstepA = (size_t)HALF * g.a_ld * 2, tstepA = 2 * hstepA;
    const unsigned ldsw = (unsigned)wid * 1024u;
    const int aoff = lds_byte(wr * 64 + fr, fq * 8), boff = lds_byte(wc * 32 + fr, fq * 8);
#define PG8_SA(b, h) (((b) * 2 + (h)) * HTB)
#define PG8_SB(b, h) ((4 + (b) * 2 + (h)) * HTB)
#define PG8_STAGE(bufoff, gbase, voff) do { _Pragma("unroll") for (int _i = 0; _i < 2; ++_i) \
        __builtin_amdgcn_global_load_lds((const unsigned*)((const char*)(gbase) + (voff)[_i]), (PG8_LAS unsigned*)(lds + (bufoff) + ldsw + _i * 8192), 16, 0, 0); } while (0)
#define PG8_LDA(dst, b, h) do { _Pragma("unroll") for (int m = 0; m < 4; ++m) _Pragma("unroll") for (int k = 0; k < 2; ++k) dst[m][k] = *(const PG8_LAS bf16x8*)(lds + PG8_SA(b, h) + aoff + m * 2048 + k * 1024); } while (0)
#define PG8_LDB(dst, b, h) do { _Pragma("unroll") for (int n = 0; n < 2; ++n) _Pragma("unroll") for (int k = 0; k < 2; ++k) dst[n][k] = *(const PG8_LAS bf16x8*)(lds + PG8_SB(b, h) + boff + n * 2048 + k * 1024); } while (0)
#define PG8_MMA(ai, bj, At, Bt) do { __builtin_amdgcn_s_setprio(1); _Pragma("unroll") for (int m = 0; m < 4; ++m) _Pragma("unroll") for (int n = 0; n < 2; ++n) _Pragma("unroll") for (int k = 0; k < 2; ++k) \
        acc[ai][bj][m][n] = __builtin_amdgcn_mfma_f32_16x16x32_bf16(Bt[n][k], At[m][k], acc[ai][bj][m][n], 0, 0, 0); __builtin_amdgcn_s_setprio(0); } while (0)
#define PG8_WAIT_V(n) asm volatile("s_waitcnt vmcnt(" #n ")" ::: "memory")
#define PG8_WAIT_L(n) asm volatile("s_waitcnt lgkmcnt(" #n ")" ::: "memory")
#define PG8_BAR __builtin_amdgcn_s_barrier()
#define PG8_SCHED __builtin_amdgcn_sched_barrier(0)
    Unit cur, nxt; int ui = 0;
    if (!S.next(0, cur)) return;
    f32x4 acc[2][2][4][2];
#pragma unroll
    for (int a = 0; a < 2; ++a)
#pragma unroll
        for (int b = 0; b < 2; ++b)
#pragma unroll
            for (int m = 0; m < 4; ++m)
#pragma unroll
                for (int n = 0; n < 2; ++n) acc[a][b][m][n] = (f32x4){0.f, 0.f, 0.f, 0.f};
    bf16x8 At[4][2], B0[2][2], B1[2][2];
    const char* cA = (const char*)g.A + (size_t)cur.pm * tstepA; const char* cB = (const char*)g.Bt + (size_t)cur.pn * tstep;
    S.a_ready(cur);
    if constexpr (SP2) {
        PG8_STAGE(PG8_SB(0, 0), cB, voffB); PG8_STAGE(PG8_SB(0, 1), cB + hstep, voffB); PG8_STAGE(PG8_SA(0, 0), cA, voffA); PG8_STAGE(PG8_SA(0, 1), cA + hstepA, voffA);
        if (wr == 1) PG8_BAR;
        PG8_WAIT_V(2); PG8_BAR;
        PG8_STAGE(PG8_SB(1, 0), cB + kstep, voffB); PG8_STAGE(PG8_SA(1, 0), cA + kstepA, voffA); PG8_STAGE(PG8_SB(1, 1), cB + hstep + kstep, voffB);
        PG8_WAIT_V(6); PG8_BAR;
    } else {
        PG8_STAGE(PG8_SB(0, 0), cB, voffB); PG8_STAGE(PG8_SA(0, 0), cA, voffA); PG8_STAGE(PG8_SB(0, 1), cB + hstep, voffB); PG8_STAGE(PG8_SA(0, 1), cA + hstepA, voffA);
        if (wr == 1) PG8_BAR;
        PG8_WAIT_V(4); PG8_BAR;
        PG8_STAGE(PG8_SB(1, 0), cB + kstep, voffB); PG8_STAGE(PG8_SA(1, 0), cA + kstepA, voffA); PG8_STAGE(PG8_SB(1, 1), cB + hstep + kstep, voffB);
        PG8_WAIT_V(6); PG8_BAR;
    }
    for (;;) {
        const bool has_next = S.next(ui + 1, nxt);
        const char* nA = has_next ? (const char*)g.A + (size_t)nxt.pm * tstepA : cA; const char* nB = has_next ? (const char*)g.Bt + (size_t)nxt.pn * tstep : cB;
        for (int t = 0; t < nt; t += 2) {
            const bool last = (t == nt - 2);
            const char* a1 = cA + (size_t)(t + 1) * kstepA;
            const char* a2 = last ? nA : cA + (size_t)(t + 2) * kstepA; const char* b2 = last ? nB : cB + (size_t)(t + 2) * kstep;
            const char* a3 = a2 + kstepA; const char* b3 = b2 + kstep;
            if (last && has_next) S.a_ready(nxt);
            if constexpr (SP2) {
            PG8_LDB(B0, 0, 0); PG8_LDB(B1, 0, 1); PG8_SCHED; PG8_LDA(At, 0, 0); PG8_STAGE(PG8_SA(1, 1), a1 + hstepA, voffA);
            PG8_WAIT_V(8); PG8_WAIT_L(0); PG8_BAR; PG8_MMA(0, 0, At, B0); PG8_MMA(0, 1, At, B1); PG8_BAR; PG8_SCHED;
            PG8_LDA(At, 0, 1); PG8_STAGE(PG8_SB(0, 0), b2, voffB); PG8_STAGE(PG8_SB(0, 1), b2 + hstep, voffB); PG8_STAGE(PG8_SA(0, 0), a2, voffA);
            PG8_WAIT_V(8); PG8_WAIT_L(0); PG8_BAR; PG8_MMA(1, 0, At, B0); PG8_MMA(1, 1, At, B1); PG8_BAR; PG8_SCHED;
            PG8_LDB(B0, 1, 0); PG8_LDB(B1, 1, 1); PG8_SCHED; PG8_LDA(At, 1, 0); PG8_STAGE(PG8_SA(0, 1), a2 + hstepA, voffA);
            PG8_WAIT_V(8); PG8_WAIT_L(0); PG8_BAR; PG8_MMA(0, 0, At, B0); PG8_MMA(0, 1, At, B1); PG8_BAR; PG8_SCHED;
            PG8_LDA(At, 1, 1); PG8_STAGE(PG8_SB(1, 0), b3, voffB); PG8_STAGE(PG8_SB(1, 1), b3 + hstep, voffB); PG8_STAGE(PG8_SA(1, 0), a3, voffA);
            PG8_WAIT_V(8); PG8_WAIT_L(0); PG8_BAR; PG8_MMA(1, 0, At, B0); PG8_MMA(1, 1, At, B1); PG8_BAR; PG8_SCHED;
            } else {
            PG8_LDB(B0, 0, 0); PG8_SCHED; PG8_LDA(At, 0, 0); PG8_STAGE(PG8_SA(1, 1), a1 + hstepA, voffA);
            PG8_WAIT_L(8); PG8_BAR; PG8_WAIT_L(0); PG8_MMA(0, 0, At, B0); PG8_BAR; PG8_SCHED;
            PG8_LDB(B1, 0, 1); PG8_STAGE(PG8_SB(0, 0), b2, voffB);
            PG8_BAR; PG8_WAIT_L(0); PG8_MMA(0, 1, At, B1); PG8_BAR;
            PG8_LDA(At, 0, 1); PG8_STAGE(PG8_SA(0, 0), a2, voffA);
            PG8_BAR; PG8_WAIT_L(0); PG8_MMA(1, 0, At, B0); PG8_BAR; PG8_SCHED;
            PG8_STAGE(PG8_SB(0, 1), b2 + hstep, voffB);
            PG8_WAIT_V(6); PG8_BAR; PG8_MMA(1, 1, At, B1); PG8_BAR;
            PG8_LDB(B0, 1, 0); PG8_SCHED; PG8_LDA(At, 1, 0); PG8_STAGE(PG8_SA(0, 1), a2 + hstepA, voffA);
            PG8_WAIT_L(8); PG8_BAR; PG8_WAIT_L(0); PG8_MMA(0, 0, At, B0); PG8_BAR; PG8_SCHED;
            PG8_LDB(B1, 1, 1); PG8_STAGE(PG8_SB(1, 0), b3, voffB);
            PG8_BAR; PG8_WAIT_L(0); PG8_MMA(0, 1, At, B1); PG8_BAR;
            PG8_LDA(At, 1, 1); PG8_STAGE(PG8_SA(1, 0), a3, voffA);
            PG8_BAR; PG8_WAIT_L(0); PG8_MMA(1, 0, At, B0); PG8_BAR; PG8_SCHED;
            PG8_STAGE(PG8_SB(1, 1), b3 + hstep, voffB);
            PG8_WAIT_V(6); PG8_BAR; PG8_MMA(1, 1, At, B1); PG8_BAR;
            }
        }
        if constexpr (ALIGN_EPI) { if (wr == 0) PG8_BAR; }
        if constexpr (!Epi::AFTER_DRAIN) { E(acc, cur, wr, wc, fr, fq); S.done(cur); }
        if (!has_next) break;
#pragma unroll
        for (int a = 0; a < 2; ++a)
#pragma unroll
            for (int b = 0; b < 2; ++b)
#pragma unroll
                for (int m = 0; m < 4; ++m)
#pragma unroll
                    for (int n = 0; n < 2; ++n) acc[a][b][m][n] = (f32x4){0.f, 0.f, 0.f, 0.f};
        cur = nxt; cA = nA; cB = nB; ++ui;
        if constexpr (ALIGN_EPI) { if (wr == 1) PG8_BAR; }
    }
    PG8_WAIT_V(0);
    if constexpr (!ALIGN_EPI) { if (wr == 0) PG8_BAR; }
    PG8_BAR;
    if constexpr (Epi::AFTER_DRAIN) { E.fused(acc, cur, wr, wc, fr, fq, lds, wid, lane); S.done(cur); }
#undef PG8_SA
#undef PG8_SB
#undef PG8_STAGE
#undef PG8_LDA
#undef PG8_LDB
#undef PG8_MMA
#undef PG8_WAIT_V
#undef PG8_WAIT_L
#undef PG8_BAR
#undef PG8_SCHED
}
}
#define GAS __attribute__((address_space(1)))
#define LAS __attribute__((address_space(3)))
typedef unsigned short bf16;
typedef unsigned v4u __attribute__((ext_vector_type(4)));
typedef float f32x4 __attribute__((ext_vector_type(4)));
typedef short bf16x8 __attribute__((ext_vector_type(8)));
typedef GAS unsigned gu32;
typedef GAS unsigned long long gu64;
#define RLX_AGENT __ATOMIC_RELAXED, __HIP_MEMORY_SCOPE_AGENT
#define LDS_WAIT() asm volatile("s_waitcnt lgkmcnt(0)" ::: "memory")
#define VM_WAIT() asm volatile("s_waitcnt vmcnt(0)" ::: "memory")
__device__ __forceinline__ unsigned long long rt() { return __builtin_amdgcn_s_memrealtime(); }
__device__ __forceinline__ unsigned f2bf(float f) { unsigned u = __builtin_bit_cast(unsigned, f); return (u + 0x7fffu + ((u >> 16) & 1u)) >> 16; }
__device__ __forceinline__ unsigned pk2(float lo, float hi) { return f2bf(lo) | (f2bf(hi) << 16); }
__device__ __forceinline__ void st_wt8(void* p, unsigned long long v) { __hip_atomic_store((unsigned long long*)p, v, __ATOMIC_RELAXED, __HIP_MEMORY_SCOPE_AGENT); }
__device__ __forceinline__ void st_wt16(void* p, v4u v) { asm volatile("global_store_dwordx4 %0, %1, off sc0 sc1\n\ts_nop 1" :: "v"(p), "v"(v) : "memory"); }
__device__ __forceinline__ void st_wt16f(void* p, f32x4 v) { asm volatile("global_store_dwordx4 %0, %1, off sc0 sc1\n\ts_nop 1" :: "v"(p), "v"(v) : "memory"); }

#define XB_TMO      128
#define XB_XCNT(j)  (256  + 64 * (j))
#define XB_XSUB(j)  (1280 + 64 * (j))
#define XB_XGEN(j)  (2304 + 64 * (j))
#define XB_TOP      3328
#define XB_TOPGEN   3392
#define XCD_BAR_WORDS 3456
#define XB_SPIN_CAP (1u << 18)

__device__ __forceinline__ unsigned xb_ld(unsigned* p)              { return __hip_atomic_load(p, __ATOMIC_RELAXED, __HIP_MEMORY_SCOPE_AGENT); }
__device__ __forceinline__ unsigned xb_add(unsigned* p, unsigned v) { return __hip_atomic_fetch_add(p, v, __ATOMIC_RELAXED, __HIP_MEMORY_SCOPE_AGENT); }
__device__ __forceinline__ unsigned xb_xcc_id() { return (unsigned)__builtin_amdgcn_s_getreg((3 << 11) | 20) & 0xFu; }
#define XB_SPIN(cond, bar) do { unsigned _sp = 0; while (cond) { __builtin_amdgcn_s_sleep(1); \
    if ((++_sp & 255u) == 0u) { if (xb_ld(&(bar)[XB_TMO])) break; if (_sp > XB_SPIN_CAP) { atomicAdd(&(bar)[XB_TMO], 1u); break; } } } } while (0)

struct XcdBarrier {
    unsigned* bar; unsigned x;
    volatile LAS unsigned* st;
};

__device__ __forceinline__ XcdBarrier xcd_barrier_post(unsigned* bar, volatile LAS unsigned* st) {
    XcdBarrier b; b.bar = bar; b.x = xb_xcc_id(); b.st = st;
    if (threadIdx.x == 0) (void)xb_add(&bar[XB_XCNT(b.x)], 1u);
    return b;
}
__device__ __forceinline__ void xcd_barrier_complete(unsigned* bar, unsigned x, unsigned& nloc, unsigned& nx) {
    const unsigned G = gridDim.x * gridDim.y * gridDim.z;
    unsigned sum, cnt, mine, sp = 0u;
    for (;;) {
        sum = 0u; cnt = 0u; mine = 0u;
#pragma unroll
        for (unsigned j = 0; j < 16; ++j) { const unsigned c = xb_ld(&bar[XB_XCNT(j)]); sum += c; cnt += (c > 0u) ? 1u : 0u; mine = (j == x) ? c : mine; }
        if (sum == G) break;
        __builtin_amdgcn_s_sleep(1);
        if ((++sp & 255u) == 0u) { if (xb_ld(&bar[XB_TMO])) break; if (sp > XB_SPIN_CAP) { atomicAdd(&bar[XB_TMO], 1u); break; } }
    }
    nloc = mine > 0u ? mine : 1u; nx = cnt > 0u ? cnt : 1u;
}

__device__ __forceinline__ void xcd_barrier(const XcdBarrier& b) {
    asm volatile("s_waitcnt vmcnt(0)" ::: "memory");
    __syncthreads();
    if (threadIdx.x == 0) {
        unsigned* bar = b.bar;
        __builtin_amdgcn_s_waitcnt(0);
        unsigned nloc = b.st[0], nx = b.st[1];
        if (nloc == 0u) { xcd_barrier_complete(bar, b.x, nloc, nx); b.st[0] = nloc; b.st[1] = nx; }
        const unsigned old = xb_add(&bar[XB_XSUB(b.x)], 1u);
        const unsigned gen = old / nloc;
        if (old + 1u == (gen + 1u) * nloc) {
            __builtin_amdgcn_fence(__ATOMIC_RELEASE, "agent");
            asm volatile("s_waitcnt vmcnt(0)" ::: "memory");
            const unsigned og = xb_add(&bar[XB_TOP], 1u);
            const unsigned tg = og / nx;
            if (og + 1u == (tg + 1u) * nx) xb_add(&bar[XB_TOPGEN], 1u);
            else XB_SPIN(xb_ld(&bar[XB_TOPGEN]) == tg, bar);
            __builtin_amdgcn_fence(__ATOMIC_ACQUIRE, "agent");
            xb_add(&bar[XB_XGEN(b.x)], 1u);
            asm volatile("s_waitcnt vmcnt(0)" ::: "memory");
        } else {
            XB_SPIN(xb_ld(&bar[XB_XGEN(b.x)]) == gen, bar);
            __builtin_amdgcn_fence(__ATOMIC_ACQUIRE, "agent");
            asm volatile("s_waitcnt vmcnt(0)" ::: "memory");
        }
    }
    __syncthreads();
}

constexpr int NWAVES = 8;
constexpr int DM = 1024, BATCH = 16, SEQ = 2048, DEC_B = 32, DEC_T = 32, PAST = 1024;
constexpr int MP = BATCH * SEQ, MS = DEC_B * DEC_T, M = MP + MS;
constexpr int NIN = 3328;
constexpr float EPS = 1e-6f, LOG2E = 1.4426950408889634f;
constexpr size_t O_Y = 0, O_AKP = 34603008, O_AVP = 34865152, O_BKP = 35127296, O_BVP = 39321600, O_CHP = 43515904, O_CCP = 43532288,
                 O_AKS = 43581440, O_AVS = 44105728, O_BKS = 44630016, O_BVS = 53018624, O_CHS = 61407232, O_CCS = 61440000, O_END = 61538304;
static_assert(O_AKP == (size_t)M * DM && O_AKP == pg8::EO_AKP && O_AVP == pg8::EO_AVP && O_BKP == pg8::EO_BKP && O_BVP == pg8::EO_BVP && O_AKS == pg8::EO_AKS && O_AVS == pg8::EO_AVS && O_BKS == pg8::EO_BKS && O_BVS == pg8::EO_BVS, "d_out map");

constexpr size_t MiB = 1u << 20;
constexpr size_t WS_CTL = 0, CTL_ZERO_BYTES = 1 * MiB;
constexpr size_t WS_WIN0 = 1 * MiB;
constexpr size_t WS_WOUT0 = 8 * MiB;
constexpr size_t WS_WIN1 = 10 * MiB;
constexpr size_t WS_WOUT1 = 14 * MiB;
constexpr size_t WS_ROPE = 16 * MiB;
constexpr size_t WS_XN = 17 * MiB;
constexpr size_t WS_MIX = 84 * MiB;
constexpr size_t WS_R1 = 151 * MiB;
constexpr size_t SZ512 = (size_t)M * 512 * 2;
constexpr size_t SZ_TA = (size_t)16 * 2 * 64 * 4096, SZ_TB = (size_t)16 * 8 * 64 * 4096, SZ_SA = (size_t)32 * 2 * 5 * 4096, SZ_SB = (size_t)32 * 8 * 17 * 4096;
constexpr size_t R_QA = 0, R_GA = R_QA + SZ512, R_QB = R_GA + SZ512, R_GB = R_QB + SZ512, R_KTA = R_GB + SZ512, R_VTA = R_KTA + SZ_TA, R_KTB = R_VTA + SZ_TA, R_VTB = R_KTB + SZ_TB,
                 R_KSA = R_VTB + SZ_TB, R_VSA = R_KSA + SZ_SA, R_KSB = R_VSA + SZ_SA, R_VSB = R_KSB + SZ_SB, R_END = R_VSB + SZ_SB;
static_assert(R_END <= 256 * MiB && R_QA == pg8::ER_QA && R_GA == pg8::ER_GA && R_QB == pg8::ER_QB && R_GB == pg8::ER_GB && R_KTA == pg8::ER_KTA && R_VTA == pg8::ER_VTA && R_KTB == pg8::ER_KTB && R_VTB == pg8::ER_VTB && R_KSA == pg8::ER_KSA && R_VSA == pg8::ER_VSA && R_KSB == pg8::ER_KSB && R_VSB == pg8::ER_VSB, "R1 region");
constexpr size_t R_M1 = 0;
constexpr size_t R_XB = 0, R_ZB = (size_t)M * 1024 * 2;
constexpr size_t WS_END = WS_R1 + 256 * MiB;
constexpr int CW_BAR = 4096;
constexpr int CW_GEMMQ = 1024;
constexpr int CW_ATTNQ = 512;

constexpr int RING_OFF = 0, RING_BYTES = 131072;
constexpr int LDSCTL_OFF = RING_BYTES, MISC_OFF = LDSCTL_OFF + 320;
constexpr int LDS_BYTES = 147456;
static_assert(MISC_OFF + 128 <= LDS_BYTES, "LDS map");

struct Args { const float* in[23]; float* out; unsigned char* ws; int ph_lo, ph_hi; };
static_assert(sizeof(Args) == 23 * 8 + 8 + 8 + 8, "Args has no padding");
struct Frame {
    LAS unsigned char* lds;
    volatile LAS unsigned* MISC;
    gu32* ctl;
    int tid, lane, wave;
    int vcu, G;
};
typedef const __attribute__((address_space(4))) Args* CArgs;
__device__ __forceinline__ CArgs kargs() { auto p = __builtin_amdgcn_kernarg_segment_ptr(); asm volatile("" : "+s"(p)); return (CArgs)p; }
#define A_IN(k) (A->in[k])
#define A_XP A_IN(0)
#define A_XS A_IN(1)
#define A_CAK A_IN(2)
#define A_CAV A_IN(3)
#define A_CBK A_IN(4)
#define A_CBV A_IN(5)
#define A_STH A_IN(6)
#define A_STCONV A_IN(7)
#define A_LNPRE A_IN(8)
#define A_LNPOST A_IN(9)
#define A_WIN0 A_IN(10)
#define A_SINKS A_IN(11)
#define A_RELPOS A_IN(12)
#define A_WOUT0 A_IN(13)
#define A_WIN1 A_IN(14)
#define A_CONVW A_IN(15)
#define A_CONVB A_IN(16)
#define A_GWA A_IN(17)
#define A_GBA A_IN(18)
#define A_GWX A_IN(19)
#define A_GBX A_IN(20)
#define A_LAM A_IN(21)
#define A_WOUT1 A_IN(22)
#define W_BF(off) ((bf16*)(A->ws + (off)))
#define W_WIN0T W_BF(WS_WIN0)
#define W_WOUT0T W_BF(WS_WOUT0)
#define W_WIN1T W_BF(WS_WIN1)
#define W_WOUT1T W_BF(WS_WOUT1)
#define W_ROPE ((float*)(A->ws + WS_ROPE))
#define W_XN W_BF(WS_XN)
#define W_MIX W_BF(WS_MIX)
#define W_QA W_BF(WS_R1 + R_QA)
#define W_GA W_BF(WS_R1 + R_GA)
#define W_QB W_BF(WS_R1 + R_QB)
#define W_GB W_BF(WS_R1 + R_GB)
#define W_KTA (A->ws + WS_R1 + R_KTA)
#define W_VTA (A->ws + WS_R1 + R_VTA)
#define W_KTB (A->ws + WS_R1 + R_KTB)
#define W_VTB (A->ws + WS_R1 + R_VTB)
#define W_KSA (A->ws + WS_R1 + R_KSA)
#define W_VSA (A->ws + WS_R1 + R_VSA)
#define W_KSB (A->ws + WS_R1 + R_KSB)
#define W_VSB (A->ws + WS_R1 + R_VSB)
#define W_M1 W_BF(WS_R1 + R_M1)
#define W_XB W_BF(WS_R1 + R_XB)
#define W_ZB W_BF(WS_R1 + R_ZB)
__device__ __forceinline__ const float* x_row(CArgs A, int m) { return m < MP ? A_XP + (size_t)m * DM : A_XS + (size_t)(m - MP) * DM; }

__device__ __forceinline__ float wave_sum(float v) {
#pragma unroll
    for (int o = 1; o < 64; o <<= 1) v += __shfl_xor(v, o);
    return v;
}
__device__ __forceinline__ float bf2f(unsigned short b) { return __uint_as_float((unsigned)b << 16); }
__device__ __forceinline__ float bflo(unsigned w) { return __uint_as_float(w << 16); }
__device__ __forceinline__ float bfhi(unsigned w) { return __uint_as_float(w & 0xffff0000u); }

__host__ __device__ __forceinline__ int rope_perm_col(int d) { const int n = d >> 5, w = (d >> 4) & 1, fq = (d >> 2) & 3, j = d & 3; return 32 * w + 8 * fq + 4 * n + j; }
__host__ __device__ __forceinline__ int win0_row(int n) { return n < 640 ? (n & ~63) + rope_perm_col(n & 63) : n; }

template <int MAP>
__device__ __forceinline__ void p0_transpose_item(const float* W, int K, int N, bf16* WT, LAS float* scr, int item, int lane, unsigned nx, int tbase, int& item_next, const float* gk = nullptr) {
    const int nblk = N / 32, kb = item / nblk, nb = item % nblk, k0 = 64 * kb, n0 = 32 * nb;
#pragma unroll 8
    for (int i = 0; i < 32; ++i) { const int kk = 2 * i + (lane >> 5); float v = W[(size_t)(k0 + kk) * N + n0 + (lane & 31)]; if (gk) v *= gk[k0 + kk]; scr[kk * 33 + (lane & 31)] = v; }
    LDS_WAIT(); asm volatile("" ::: "memory");
    item_next = tbase + NWAVES * (int)__builtin_amdgcn_readfirstlane((int)nx);
    const int c = lane & 7;
#pragma unroll
    for (int j = 0; j < 4; ++j) { const int n = (lane >> 3) + 8 * j; const LAS float* s = scr + (8 * c) * 33 + n;
        v4u o; o.x = pk2(s[0 * 33], s[1 * 33]); o.y = pk2(s[2 * 33], s[3 * 33]); o.z = pk2(s[4 * 33], s[5 * 33]); o.w = pk2(s[6 * 33], s[7 * 33]);
        const int drow = MAP ? win0_row(n0 + n) : (n0 + n);
        st_wt16((void*)(WT + (size_t)drow * K + k0 + 8 * c), o); }
    LDS_WAIT(); asm volatile("" ::: "memory");
}
__device__ __forceinline__ void rms_row_to_bf16(int lane, const float* xrow, const float* g, bf16* orow) {
    const GAS f32x4* xr = (const GAS f32x4*)xrow + lane; const GAS f32x4* gr = (const GAS f32x4*)g + lane;
    f32x4 v[4]; float s = 0.f;
#pragma unroll
    for (int j = 0; j < 4; ++j) { v[j] = xr[64 * j]; s += (v[j].x * v[j].x + v[j].y * v[j].y) + (v[j].z * v[j].z + v[j].w * v[j].w); }
    const float rstd = 1.0f / sqrtf(wave_sum(s) * (1.f / DM) + EPS);
    GAS unsigned long long* o8 = (GAS unsigned long long*)orow + lane;
#pragma unroll
    for (int j = 0; j < 4; ++j) { const f32x4 gg = gr[64 * j]; const f32x4 y = v[j] * rstd * gg; o8[64 * j] = (unsigned long long)pk2(y.x, y.y) | ((unsigned long long)pk2(y.z, y.w) << 32); }
}
__constant__ float kRopeInv[32] = {0x1.0000000000000p+0f, 0x1.7ff2240000000p-1f, 0x1.1feb340000000p-1f, 0x1.afd1360000000p-2f, 0x1.43d1360000000p-2f, 0x1.e5a8480000000p-3f, 0x1.6c310e0000000p-3f, 0x1.111aec0000000p-3f,
    0x1.99999a0000000p-4f, 0x1.33281a0000000p-4f, 0x1.ccab860000000p-5f, 0x1.59742c0000000p-5f, 0x1.030dc40000000p-5f, 0x1.8486a00000000p-6f, 0x1.235a720000000p-6f, 0x1.b4f7e40000000p-7f,
    0x1.47ae140000000p-7f, 0x1.eb735e0000000p-8f, 0x1.7089380000000p-8f, 0x1.145cee0000000p-8f, 0x1.9e7c6e0000000p-9f, 0x1.36d2180000000p-9f, 0x1.d22a500000000p-10f, 0x1.5d931c0000000p-10f,
    0x1.0624de0000000p-10f, 0x1.89291a0000000p-11f, 0x1.26d42c0000000p-11f, 0x1.ba2e4c0000000p-12f, 0x1.4b96be0000000p-12f, 0x1.f150280000000p-13f, 0x1.74eea60000000p-13f, 0x1.17a8e40000000p-13f};
__device__ __forceinline__ void sincos_acc(float angf, float& c, float& s) {
    const double a = (double)angf; const double k = __builtin_rint(a * 0.63661977236758134308);
    const double r = __builtin_fma(-k, 6.123233995736766e-17, __builtin_fma(-k, 1.5707963267948966, a));
    const double r2 = r * r;
    double sp = -1.0 / 1307674368000.0; sp = sp * r2 + 1.0 / 6227020800.0; sp = sp * r2 - 1.0 / 39916800.0; sp = sp * r2 + 1.0 / 362880.0; sp = sp * r2 - 1.0 / 5040.0; sp = sp * r2 + 1.0 / 120.0; sp = sp * r2 - 1.0 / 6.0; sp = sp * r2 + 1.0;
    const double sr = sp * r;
    double cp = 1.0 / 20922789888000.0; cp = cp * r2 - 1.0 / 87178291200.0; cp = cp * r2 + 1.0 / 479001600.0; cp = cp * r2 - 1.0 / 3628800.0; cp = cp * r2 + 1.0 / 40320.0; cp = cp * r2 - 1.0 / 720.0; cp = cp * r2 + 1.0 / 24.0; cp = cp * r2 - 0.5; cp = cp * r2 + 1.0;
    const int q = ((int)k) & 3;
    const double cc = (q == 0) ? cp : (q == 1) ? -sr : (q == 2) ? -cp : sr;
    const double ss = (q == 0) ? sr : (q == 1) ? cp : (q == 2) ? -sr : -cp;
    c = (float)cc; s = (float)ss;
}

constexpr int CW_P0Q = 2048;
__device__ __forceinline__ void p0_prologue(Frame& F, CArgs A) {
    LAS float* scr = (LAS float*)(F.lds + RING_OFF + F.wave * 16384);
    const int gw = F.vcu * NWAVES + F.wave;
    constexpr int I_0 = (DM / 64) * (NIN / 32), I_1 = (DM / 64) * (DM / 32), I_2 = (DM / 64) * (2 * DM / 32), I_3 = I_1;
    constexpr int N_XN = M / 4, N_TR = I_0 + I_1 + I_2 + I_3, N_CB = 32 * 512 * 512 / 4 / 64 / 4, N_CA = 32 * 128 * 128 / 4 / 64 / 4, N_RP = 2048 * 32 / 64 / 4, N_ALL = N_XN + N_TR + N_RP;
    static_assert(M % 4 == 0 && N_ALL % NWAVES == 0, "prologue item list");
    unsigned* qctr = (unsigned*)(F.ctl + CW_P0Q + 64 * F.wave);
    const int tbase = F.G * NWAVES + F.wave;
    f32x4 g[4];
#pragma unroll
    for (int j = 0; j < 4; ++j) g[j] = ((const GAS f32x4*)A_LNPRE + F.lane)[64 * j];
    int item = gw;
    while (item < N_ALL) {
        int lane = F.lane; asm volatile("" : "+v"(lane));
        const unsigned nx = lane == 0 ? __hip_atomic_fetch_add(qctr, 1u, __ATOMIC_RELAXED, __HIP_MEMORY_SCOPE_AGENT) : 0u;
        int item_next; int r = item;
        if (r < N_RP) {
            const float inv = kRopeInv[lane & 31];
            item_next = tbase + NWAVES * (int)__builtin_amdgcn_readfirstlane((int)nx);
            for (int u = 0; u < 4; ++u) { const int i = (r * 4 + u) * 64 + lane; const int pos = i >> 5, k = i & 31; const float ang = (float)pos * inv; float c, sn; sincos_acc(ang, c, sn); W_ROPE[pos * 64 + k] = c; W_ROPE[pos * 64 + 32 + k] = sn; }
        } else if ((r -= N_RP) < N_XN) {
            const int rb = 4 * r; f32x4 v[4][4]; float rstd[4];
#pragma unroll
            for (int q = 0; q < 4; ++q) { const GAS f32x4* xr = (const GAS f32x4*)x_row(A, rb + q) + lane;
#pragma unroll
                for (int j = 0; j < 4; ++j) v[q][j] = xr[64 * j]; }
#pragma unroll
            for (int q = 0; q < 4; ++q) { float ss = 0.f;
#pragma unroll
                for (int j = 0; j < 4; ++j) ss += (v[q][j].x * v[q][j].x + v[q][j].y * v[q][j].y) + (v[q][j].z * v[q][j].z + v[q][j].w * v[q][j].w);
                rstd[q] = 1.0f / sqrtf(wave_sum(ss) * (1.f / DM) + EPS); }
            item_next = tbase + NWAVES * (int)__builtin_amdgcn_readfirstlane((int)nx);
#pragma unroll
            for (int q = 0; q < 4; ++q) { GAS unsigned long long* o8 = (GAS unsigned long long*)(W_XN + (size_t)(rb + q) * DM) + lane;
#pragma unroll
                for (int j = 0; j < 4; ++j) { const f32x4 y = v[q][j] * rstd[q] * g[j]; st_wt8((void*)(o8 + 64 * j), (unsigned long long)pk2(y.x, y.y) | ((unsigned long long)pk2(y.z, y.w) << 32)); } }
        } else if ((r -= N_XN) < N_TR) {
            if (r < I_0) p0_transpose_item<1>(A_WIN0, DM, NIN, W_WIN0T, scr, r, lane, nx, tbase, item_next);
            else if ((r -= I_0) < I_1) p0_transpose_item<0>(A_WOUT0, DM, DM, W_WOUT0T, scr, r, lane, nx, tbase, item_next);
            else if ((r -= I_1) < I_2) p0_transpose_item<0>(A_WIN1, DM, 2 * DM, W_WIN1T, scr, r, lane, nx, tbase, item_next, A_LNPRE + DM);
            else p0_transpose_item<0>(A_WOUT1, DM, DM, W_WOUT1T, scr, r - I_2, lane, nx, tbase, item_next);
        }
        item = item_next;
    }
}

constexpr int CW_CQ = 2560;
__device__ __forceinline__ void cache_tail(Frame& F, CArgs A) {
    const int gw = F.vcu * NWAVES + F.wave;
    constexpr int N_CB = 32 * 512 * 512 / 4 / 64 / 4, N_CA = 32 * 128 * 128 / 4 / 64 / 4, N_ALL = N_CB + N_CA;
    static_assert(N_ALL % NWAVES == 0, "cache item list");
    unsigned* qctr = (unsigned*)(F.ctl + CW_CQ + 64 * F.wave);
    const int tbase = F.G * NWAVES + F.wave;
    int item = gw;
    while (item < N_ALL) {
        int lane = F.lane; asm volatile("" : "+v"(lane));
        const unsigned nx = lane == 0 ? __hip_atomic_fetch_add(qctr, 1u, __ATOMIC_RELAXED, __HIP_MEMORY_SCOPE_AGENT) : 0u;
        int item_next; int r = item;
        if (r < N_CB) {
            f32x4 k4[4], v4[4];
#pragma unroll
            for (int u = 0; u < 4; ++u) { const int e = ((r * 4 + u) * 64 + lane) * 4; k4[u] = *(const GAS f32x4*)(A_CBK + e); v4[u] = *(const GAS f32x4*)(A_CBV + e); }
            float touch = 0.f;
#pragma unroll
            for (int u = 0; u < 4; ++u) touch += k4[u].x + v4[u].x;
            asm volatile("" :: "v"(touch));
            item_next = tbase + NWAVES * (int)__builtin_amdgcn_readfirstlane((int)nx);
#pragma unroll
            for (int u = 0; u < 4; ++u) { const int e = ((r * 4 + u) * 64 + lane) * 4, b = e >> 18, rr = (e >> 9) & 511, col = e & 511, h = col >> 6, d = col & 63;
                const size_t tb = (size_t)((b * 8 + h) * 17 + (rr >> 5)) * 4096; const int key = rr & 31;
                st_wt8((void*)(W_KSB + tb + (d >> 3) * 512 + key * 16 + (d & 7) * 2), (unsigned long long)pk2(k4[u].x, k4[u].y) | ((unsigned long long)pk2(k4[u].z, k4[u].w) << 32));
                st_wt8((void*)(W_VSB + tb + (d >> 5) * 2048 + key * 64 + (d & 31) * 2), (unsigned long long)pk2(v4[u].x, v4[u].y) | ((unsigned long long)pk2(v4[u].z, v4[u].w) << 32));
                if (rr >= 32) { const size_t fo = (size_t)(b * 512 + rr - 32) * 512 + col; st_wt16f((void*)(A->out + O_BKS + fo), k4[u]); st_wt16f((void*)(A->out + O_BVS + fo), v4[u]); } }
        } else {
            r -= N_CB;
            f32x4 k4[4], v4[4];
#pragma unroll
            for (int u = 0; u < 4; ++u) { const int e = ((r * 4 + u) * 64 + lane) * 4; k4[u] = *(const GAS f32x4*)(A_CAK + e); v4[u] = *(const GAS f32x4*)(A_CAV + e); }
            float touch = 0.f;
#pragma unroll
            for (int u = 0; u < 4; ++u) touch += k4[u].x + v4[u].x;
            asm volatile("" :: "v"(touch));
            item_next = tbase + NWAVES * (int)__builtin_amdgcn_readfirstlane((int)nx);
#pragma unroll
            for (int u = 0; u < 4; ++u) { const int e = ((r * 4 + u) * 64 + lane) * 4, b = e >> 14, rr = (e >> 7) & 127, col = e & 127, kvh = col >> 6, d = col & 63;
                const size_t tb = (size_t)((b * 2 + kvh) * 5 + (rr >> 5)) * 4096; const int key = rr & 31;
                st_wt8((void*)(W_KSA + tb + (d >> 3) * 512 + key * 16 + (d & 7) * 2), (unsigned long long)pk2(k4[u].x, k4[u].y) | ((unsigned long long)pk2(k4[u].z, k4[u].w) << 32));
                st_wt8((void*)(W_VSA + tb + (d >> 5) * 2048 + key * 64 + (d & 31) * 2), (unsigned long long)pk2(v4[u].x, v4[u].y) | ((unsigned long long)pk2(v4[u].z, v4[u].w) << 32));
                if (rr >= 32) { const size_t fo = (size_t)(b * 128 + rr - 32) * 128 + col; st_wt16f((void*)(A->out + O_AKS + fo), k4[u]); st_wt16f((void*)(A->out + O_AVS + fo), v4[u]); } }
        }
        item = item_next;
    }
}

typedef float f32x16 __attribute__((ext_vector_type(16)));
typedef short s16x4 __attribute__((ext_vector_type(4)));
typedef short v4i16_t __attribute__((ext_vector_type(4)));
typedef float f32x2_t __attribute__((ext_vector_type(2))); typedef __bf16 bf16x2_t __attribute__((ext_vector_type(2)));
__device__ __forceinline__ unsigned cvtpk_s(float lo, float hi) { f32x2_t v = {lo, hi}; bf16x2_t b = __builtin_convertvector(v, bf16x2_t); return __builtin_bit_cast(unsigned, b); }
__device__ __forceinline__ s16x4 vtr(const LAS unsigned char* p) { return __builtin_bit_cast(s16x4, __builtin_amdgcn_ds_read_tr16_b64_v4i16((LAS v4i16_t*)p)); }
__device__ __forceinline__ float swap_max(float v) { auto rr = __builtin_amdgcn_permlane32_swap(__float_as_uint(v), __float_as_uint(v), false, false); return fmaxf(__uint_as_float(rr[0]), __uint_as_float(rr[1])); }
__device__ __forceinline__ float swap_add(float v) { auto rr = __builtin_amdgcn_permlane32_swap(__float_as_uint(v), __float_as_uint(v), false, false); return __uint_as_float(rr[0]) + __uint_as_float(rr[1]); }
__constant__ unsigned char kAttnTab[16][8] = {{0x8, 0x18, 0x2f, 0x3f, 0xff, 0xff, 0xff, 0xff}, {0x9, 0x19, 0x30, 0x1, 0xff, 0xff, 0xff, 0xff}, {0xa, 0x1a, 0x31, 0x21, 0xff, 0xff, 0xff, 0xff}, {0xb, 0x1b, 0x32, 0x60, 0xff, 0xff, 0xff, 0xff},
    {0xc, 0x1c, 0x33, 0x61, 0xff, 0xff, 0xff, 0xff}, {0xd, 0x1d, 0x34, 0x0, 0xff, 0xff, 0xff, 0xff}, {0xe, 0x1e, 0x35, 0x20, 0xff, 0xff, 0xff, 0xff}, {0xf, 0x1f, 0x36, 0xff, 0xff, 0xff, 0xff, 0xff},
    {0x10, 0x7, 0x2b, 0x3b, 0xff, 0xff, 0xff, 0xff}, {0x11, 0x6, 0x29, 0x39, 0xff, 0xff, 0xff, 0xff}, {0x12, 0x5, 0x27, 0x37, 0xff, 0xff, 0xff, 0xff}, {0x13, 0x4, 0x26, 0x2e, 0x3e, 0xff, 0xff, 0xff},
    {0x14, 0x40, 0x24, 0x2c, 0x3c, 0xff, 0xff, 0xff}, {0x15, 0x41, 0x25, 0x2d, 0x3d, 0xff, 0xff, 0xff}, {0x16, 0x3, 0x23, 0x2a, 0x3a, 0xff, 0xff, 0xff}, {0x17, 0x2, 0x22, 0x28, 0x38, 0xff, 0xff, 0xff}};
__device__ __forceinline__ void glds16x4(const void* gsrc, unsigned lds_dst) { unsigned keep;
    asm volatile("s_mov_b32 %0, m0\n\ts_mov_b32 m0, %2\n\ts_nop 0\n\tglobal_load_lds_dwordx4 %1, off\n\tglobal_load_lds_dwordx4 %1, off offset:1024\n\tglobal_load_lds_dwordx4 %1, off offset:2048\n\tglobal_load_lds_dwordx4 %1, off offset:3072\n\ts_mov_b32 m0, %0"
                 : "=&s"(keep) : "v"(gsrc), "s"(lds_dst) : "memory"); }
constexpr int BTAB_OFF = 132096;
static_assert(BTAB_OFF >= MISC_OFF + 128 && BTAB_OFF + 8 * 260 * 4 <= LDS_BYTES, "bias table in LDS");
__device__ __forceinline__ float max3f(float a, float b, float c) { float r; asm("v_max3_f32 %0, %1, %2, %3" : "=v"(r) : "v"(a), "v"(b), "v"(c)); return r; }
__device__ __forceinline__ float rowmax16(const f32x16& S) {
    float a = max3f(S[0], S[1], S[2]), b = max3f(S[3], S[4], S[5]); a = max3f(a, S[6], S[7]); b = max3f(b, S[8], S[9]); a = max3f(a, S[10], S[11]); b = max3f(b, S[12], S[13]); a = max3f(a, S[14], S[15]);
    return swap_max(fmaxf(a, b));
}
__device__ __forceinline__ void attn_block_step(const bf16x8 (&qr)[4], f32x16& o0, f32x16& o1, f32x16& lacc, float& mref, bool first, bool biased, int i0, const LAS float* bt,
                                                const bf16x8 (&kc)[4], const bf16x8 (&vf)[4]) {
    constexpr float THR = 8.0f;
    f32x16 S;
#pragma unroll
    for (int r = 0; r < 16; ++r) S[r] = -mref;
#pragma unroll
    for (int d0 = 0; d0 < 4; ++d0) S = __builtin_amdgcn_mfma_f32_32x32x16_bf16(kc[d0], qr[d0], S, 0, 0, 0);
    if (biased) {
#pragma unroll
        for (int r = 0; r < 16; ++r) { int ix = i0 - ((r & 3) + 8 * (r >> 2)); ix = ix < 0 ? 0 : (ix > 256 ? 256 : ix); S[r] += bt[ix]; }
    }
    float mx = rowmax16(S);
    if (first) {
        mref = mx;
#pragma unroll
        for (int r = 0; r < 16; ++r) S[r] -= mx;
    } else if (__any(mx > THR)) {
        const float dl = fmaxf(mx, 0.f), alpha = __builtin_amdgcn_exp2f(-dl); mref += dl;
#pragma unroll
        for (int r = 0; r < 16; ++r) { S[r] -= dl; o0[r] *= alpha; o1[r] *= alpha; lacc[r] *= alpha; }
    }
#pragma unroll
    for (int r = 0; r < 16; ++r) S[r] = __builtin_amdgcn_exp2f(S[r]);
    v4u pw0, pw1;
    pw0.x = cvtpk_s(S[0], S[1]); pw0.y = cvtpk_s(S[2], S[3]); pw0.z = cvtpk_s(S[4], S[5]); pw0.w = cvtpk_s(S[6], S[7]);
    pw1.x = cvtpk_s(S[8], S[9]); pw1.y = cvtpk_s(S[10], S[11]); pw1.z = cvtpk_s(S[12], S[13]); pw1.w = cvtpk_s(S[14], S[15]);
    const bf16x8 pb0 = __builtin_bit_cast(bf16x8, pw0), pb1 = __builtin_bit_cast(bf16x8, pw1);
    const bf16x8 ones = (bf16x8){(short)0x3F80, (short)0x3F80, (short)0x3F80, (short)0x3F80, (short)0x3F80, (short)0x3F80, (short)0x3F80, (short)0x3F80};
    lacc = __builtin_amdgcn_mfma_f32_32x32x16_bf16(ones, pb0, lacc, 0, 0, 0);
    lacc = __builtin_amdgcn_mfma_f32_32x32x16_bf16(ones, pb1, lacc, 0, 0, 0);
    o0 = __builtin_amdgcn_mfma_f32_32x32x16_bf16(vf[0], pb0, o0, 0, 0, 0);
    o0 = __builtin_amdgcn_mfma_f32_32x32x16_bf16(vf[1], pb1, o0, 0, 0, 0);
    o1 = __builtin_amdgcn_mfma_f32_32x32x16_bf16(vf[2], pb0, o1, 0, 0, 0);
    o1 = __builtin_amdgcn_mfma_f32_32x32x16_bf16(vf[3], pb1, o1, 0, 0, 0);
}
__device__ __forceinline__ void attn_block_out(const f32x16& o0, const f32x16& o1, const f32x16& lacc, float mref, bool isB, float sk, const bf16* grow, bf16* mrow, LAS unsigned char* stg, int lane) {
    float l = lacc[0]; float oscale;
    if (!isB) { const float mf = fmaxf(mref, sk), sc = __builtin_amdgcn_exp2f(mref - mf); l = l * sc + __builtin_amdgcn_exp2f(sk - mf); oscale = sc / l; }
    else oscale = 1.0f / l;
    const int q32 = lane & 31, hi = lane >> 5;
    LAS unsigned char* wp = stg + q32 * 144 + 8 * hi;
#pragma unroll
    for (int g = 0; g < 4; ++g) {
        *(LAS unsigned long long*)(wp + 16 * g) = (unsigned long long)cvtpk_s(o0[4 * g] * oscale, o0[4 * g + 1] * oscale) | ((unsigned long long)cvtpk_s(o0[4 * g + 2] * oscale, o0[4 * g + 3] * oscale) << 32);
        *(LAS unsigned long long*)(wp + 64 + 16 * g) = (unsigned long long)cvtpk_s(o1[4 * g] * oscale, o1[4 * g + 1] * oscale) | ((unsigned long long)cvtpk_s(o1[4 * g + 2] * oscale, o1[4 * g + 3] * oscale) << 32);
    }
    const int rr = lane >> 3, ch = lane & 7;
    v4u gv[4];
#pragma unroll
    for (int i = 0; i < 4; ++i) gv[i] = *(const GAS v4u*)(grow + (size_t)(8 * i + rr) * 512 + 8 * ch);
    LDS_WAIT(); asm volatile("" ::: "memory");
#pragma unroll
    for (int i = 0; i < 4; ++i) { const v4u ov = *(const LAS v4u*)(stg + (8 * i + rr) * 144 + 16 * ch); v4u r;
        r.x = cvtpk_s(bflo(ov.x) * bflo(gv[i].x), bfhi(ov.x) * bfhi(gv[i].x)); r.y = cvtpk_s(bflo(ov.y) * bflo(gv[i].y), bfhi(ov.y) * bfhi(gv[i].y));
        r.z = cvtpk_s(bflo(ov.z) * bflo(gv[i].z), bfhi(ov.z) * bfhi(gv[i].z)); r.w = cvtpk_s(bflo(ov.w) * bflo(gv[i].w), bfhi(ov.w) * bfhi(gv[i].w));
        st_wt16((void*)(mrow + (size_t)(8 * i + rr) * 1024 + 8 * ch), r); }
}
__device__ __forceinline__ void attn_mfma_phase(Frame& F, CArgs A) {
    const int lane0 = F.lane; const int gw = F.vcu * NWAVES + F.wave, NGW = F.G * NWAVES;
    LAS unsigned char* ring = F.lds + RING_OFF + F.wave * 16384;
    const unsigned ring_a = (unsigned)(uintptr_t)ring;
    LAS float* btab = (LAS float*)(F.lds + BTAB_OFF);
    for (int i = F.tid; i < 8 * 257; i += NWAVES * 64) { const int hh = i / 257; btab[hh * 260 + (i - hh * 257)] = (A_RELPOS[i] - A_RELPOS[hh * 257 + 256]) * LOG2E; }
    __syncthreads();
    unsigned* qctr = (unsigned*)(F.ctl + CW_ATTNQ + 64 * ((int)blockIdx.x & 7));
    int ticket = gw;
    {
        while (ticket < 8704) {
            int lane = lane0; asm volatile("" : "+v"(lane));
            const unsigned nxt = lane0 == 0 ? __hip_atomic_fetch_add(qctr, 1u, __ATOMIC_RELAXED, __HIP_MEMORY_SCOPE_AGENT) : 0u;
            bool isB, sample; int b, h, c, bs;
            if (ticket < 4096) { isB = true; sample = false; c = 31 - (ticket >> 7); b = (ticket >> 3) & 15; h = ticket & 7; bs = 0; }
            else if (ticket < 4352) { const int t2 = ticket - 4096; isB = true; sample = true; c = 0; b = 0; bs = t2 >> 3; h = t2 & 7; }
            else if (ticket < 8448) { const int t2 = ticket - 4352; isB = false; sample = false; c = 31 - (t2 >> 7); b = (t2 >> 3) & 15; h = t2 & 7; bs = 0; }
            else { const int t2 = ticket - 8448; isB = false; sample = true; c = 0; b = 0; bs = t2 >> 3; h = t2 & 7; }
            const int q32 = lane & 31, hi = lane >> 5;
            const size_t qrow0 = (sample ? (size_t)(MP + bs * 32) : (size_t)(b * 2048 + c * 64)) + q32;
            const bf16* qp = (isB ? W_QB : W_QA) + qrow0 * 512 + h * 64 + hi * 8;
            const unsigned char *kt, *vt; int st_lo, st_hi, kpos0;
            if (!sample) {
                if (isB) { const size_t o = (size_t)((b * 8 + h) * 64) * 4096; kt = W_KTB + o; vt = W_VTB + o; st_lo = (c - 8) * 2; }
                else { const size_t o = (size_t)((b * 2 + (h >> 2)) * 64) * 4096; kt = W_KTA + o; vt = W_VTA + o; st_lo = (c - 2) * 2; }
                if (st_lo < 0) st_lo = 0; st_hi = (c + 1) * 2; kpos0 = 0;
            } else {
                if (isB) { const size_t o = (size_t)((bs * 8 + h) * 17) * 4096; kt = W_KSB + o; vt = W_VSB + o; st_hi = 17; kpos0 = 512; }
                else { const size_t o = (size_t)((bs * 2 + (h >> 2)) * 5) * 4096; kt = W_KSA + o; vt = W_VSA + o; st_hi = 5; kpos0 = 896; }
                st_lo = 0;
            }
#define ATT_DMA(st_, so_) do { const unsigned char* kp_ = kt + (size_t)(st_) * 4096 + lane * 16; const unsigned char* vp_ = vt + (size_t)(st_) * 4096 + lane * 16; \
                const unsigned d_ = (unsigned)__builtin_amdgcn_readfirstlane((int)(ring_a + (so_))); \
                glds16x4(kp_, d_); glds16x4(vp_, d_ + 4096); } while (0)
            const int nst = st_hi - st_lo; int off = (nst - (st_lo % nst)) % nst;
            int off1 = off + 1 == nst ? 0 : off + 1;
            ATT_DMA(st_lo + off, 0);
            if (nst > 1) ATT_DMA(st_lo + off1, 8192);
            bf16x8 qa[4], qb[4];
#pragma unroll
            for (int d0 = 0; d0 < 4; ++d0) { qa[d0] = *(const GAS bf16x8*)(qp + d0 * 16); qb[d0] = *(const GAS bf16x8*)(qp + (sample ? 0 : 32 * 512) + d0 * 16); }
            const int qbase = sample ? PAST : c * 64;
            const LAS float* bt = btab + h * 260;
            float mra = 0.f, mrb = 0.f; f32x16 oa0, oa1, la, ob0, ob1, lb;
#pragma unroll
            for (int r = 0; r < 16; ++r) { oa0[r] = 0.f; oa1[r] = 0.f; la[r] = 0.f; ob0[r] = 0.f; ob1[r] = 0.f; lb[r] = 0.f; }
            const int vlane = 4096 + ((lane >> 4) & 1) * 32 + (lane & 3) * 8 + (4 * hi + ((lane & 15) >> 2)) * 64;
            for (int i = 0; i < nst; ++i) {
                const int st = st_lo + off; const int off2 = off1 + 1 == nst ? 0 : off1 + 1;
                const int cur = (i & 1) * 8192;
                if (i + 1 < nst) asm volatile("s_waitcnt vmcnt(8)" ::: "memory");
                else asm volatile("s_waitcnt vmcnt(0)" ::: "memory");
                bf16x8 kc[4], vf[4];
                { const LAS unsigned char* kb = ring + cur + lane * 16;
#pragma unroll
                  for (int d0 = 0; d0 < 4; ++d0) kc[d0] = *(const LAS bf16x8*)(kb + d0 * 1024);
                  const LAS unsigned char* vb = ring + cur + vlane;
#pragma unroll
                  for (int j = 0; j < 4; ++j) { const s16x4 x0 = vtr(vb + j * 1024), x1 = vtr(vb + j * 1024 + 512); vf[j] = (bf16x8){x0[0], x0[1], x0[2], x0[3], x1[0], x1[1], x1[2], x1[3]}; } }
                if (i + 2 < nst) {
                    asm volatile("s_waitcnt lgkmcnt(0)" : "+v"(kc[0]), "+v"(kc[1]), "+v"(kc[2]), "+v"(kc[3]), "+v"(vf[0]), "+v"(vf[1]), "+v"(vf[2]), "+v"(vf[3]) :: "memory");
                    ATT_DMA(st_lo + off2, cur);
                }
                off = off1; off1 = off2;
                const int kbase = kpos0 + st * 32; const bool first = i == 0;
                const int i0 = qbase + q32 - kbase - 4 * hi + 128;
                attn_block_step(qa, oa0, oa1, la, mra, first, isB && (qbase - kbase - 31 < 128), i0, bt, kc, vf);
                if (!sample) attn_block_step(qb, ob0, ob1, lb, mrb, first, isB && (qbase + 32 - kbase - 31 < 128), i0 + 32, bt, kc, vf);
            }
#undef ATT_DMA
            const int ticket_next = NGW + 8 * (int)__builtin_amdgcn_readfirstlane((int)nxt) + ((int)blockIdx.x & 7);
            const float sk = isB ? 0.f : A_SINKS[h] * LOG2E;
            const size_t qr0 = qrow0 - q32;
            const bf16* gp = (isB ? W_GB : W_GA) + qr0 * 512 + h * 64; bf16* mp = W_MIX + qr0 * 1024 + (isB ? 512 : 0) + h * 64;
            asm volatile("s_waitcnt lgkmcnt(0)" ::: "memory");
            attn_block_out(oa0, oa1, la, mra, isB, sk, gp, mp, ring, lane);
            if (!sample) attn_block_out(ob0, ob1, lb, mrb, isB, sk, gp + 32 * 512, mp + 32 * 1024, ring + 4608, lane);
            LDS_WAIT(); asm volatile("" ::: "memory");
            ticket = ticket_next;
        }
    }
}

#define W_RS2 ((float*)(A->ws + WS_ROPE + 512 * 1024))
template <int LAYER>
__device__ __forceinline__ void rowpass_phase(Frame& F, CArgs A) {
    int lane = F.lane; asm volatile("" : "+v"(lane));
    const int gw = F.vcu * NWAVES + F.wave, NGW = F.G * NWAVES;
    const int r0 = (int)(((long)gw * M) / NGW), r1 = (int)(((long)(gw + 1) * M) / NGW);
    const GAS f32x4* gp = (const GAS f32x4*)(A_LNPOST + LAYER * DM) + lane;
    f32x4 g[4];
#pragma unroll
    for (int j = 0; j < 4; ++j) g[j] = gp[64 * j];
    for (int rb = r0; rb < r1; rb += 4) {
        const int nr = r1 - rb < 4 ? r1 - rb : 4;
        unsigned long long mw[4][4]; f32x4 bs[4][4]; unsigned long long bw[4][4]; float rms1[4];
#pragma unroll
        for (int q = 0; q < 4; ++q) if (q < nr) { const int m = rb + q;
            const GAS unsigned long long* mr = (const GAS unsigned long long*)(W_M1 + (size_t)m * DM) + lane;
#pragma unroll
            for (int j = 0; j < 4; ++j) mw[q][j] = mr[64 * j];
            if (LAYER == 0) { const GAS f32x4* br = (const GAS f32x4*)x_row(A, m) + lane;
#pragma unroll
                for (int j = 0; j < 4; ++j) bs[q][j] = br[64 * j]; }
            else { const GAS unsigned long long* br = (const GAS unsigned long long*)(W_XN + (size_t)m * DM) + lane;
#pragma unroll
                for (int j = 0; j < 4; ++j) bw[q][j] = br[64 * j]; rms1[q] = W_RS2[m]; } }
#pragma unroll
        for (int q = 0; q < 4; ++q) if (q < nr) { const int m = rb + q;
            f32x4 v[4]; float ss = 0.f;
#pragma unroll
            for (int j = 0; j < 4; ++j) { const unsigned lo = (unsigned)mw[q][j], hi = (unsigned)(mw[q][j] >> 32); v[j] = (f32x4){bflo(lo), bfhi(lo), bflo(hi), bfhi(hi)};
                ss += (v[j].x * v[j].x + v[j].y * v[j].y) + (v[j].z * v[j].z + v[j].w * v[j].w); }
            const float rstd = 1.0f / sqrtf(wave_sum(ss) * (1.f / DM) + EPS);
            if (LAYER == 0) {
                float s2 = 0.f; GAS unsigned long long* o8 = (GAS unsigned long long*)(W_XN + (size_t)m * DM) + lane;
                f32x4 y[4];
#pragma unroll
                for (int j = 0; j < 4; ++j) { y[j] = bs[q][j] + v[j] * rstd * g[j]; s2 += (y[j].x * y[j].x + y[j].y * y[j].y) + (y[j].z * y[j].z + y[j].w * y[j].w); }
                const float ms = wave_sum(s2) * (1.f / DM) + EPS, r2 = 1.0f / sqrtf(ms);
#pragma unroll
                for (int j = 0; j < 4; ++j) { const f32x4 yn = y[j] * r2; st_wt8((void*)(o8 + 64 * j), (unsigned long long)pk2(yn.x, yn.y) | ((unsigned long long)pk2(yn.z, yn.w) << 32)); }
                if (lane == 0) W_RS2[m] = sqrtf(ms);
            } else {
                GAS f32x4* yo = (GAS f32x4*)(A->out + (size_t)m * DM) + lane;
#pragma unroll
                for (int j = 0; j < 4; ++j) { const unsigned lo = (unsigned)bw[q][j], hi = (unsigned)(bw[q][j] >> 32); const f32x4 y1 = (f32x4){bflo(lo), bfhi(lo), bflo(hi), bfhi(hi)} * rms1[q];
                    st_wt16f((void*)(yo + 64 * j), y1 + v[j] * rstd * g[j]); }
            } }
    }
}

__device__ __forceinline__ float sigmoid_fast(float v) { return __builtin_amdgcn_rcpf(1.0f + __builtin_amdgcn_exp2f(-LOG2E * v)); }
__device__ __forceinline__ void lru_phase(Frame& F, CArgs A) {
    int lane = F.lane; asm volatile("" : "+v"(lane)); const int w = F.wave; const int c16 = lane & 15, fq = lane >> 4;
    LAS float* xcs = (LAS float*)(F.lds + RING_OFF) + w * 3072;
    LAS float* as_ = xcs + 1024; LAS float* us_ = xcs + 2048;
    LAS float* segs = (LAS float*)(F.lds + RING_OFF + 98304);
    bf16x8 wf[8][2]; float bav[4], bxv[4], c8v[4]; float cb = 0.f, cw0 = 0.f, cw1 = 0.f, cw2 = 0.f, cw3 = 0.f; int n_loaded = -1;
    for (int unit = blockIdx.x; unit < 768; unit += F.G) {
        const bool sample = unit >= 256; const int uu = sample ? unit - 256 : unit; const int b = uu >> 4, n = uu & 15;
        const int T = sample ? DEC_T : SEQ; const int m0 = sample ? MP + b * DEC_T : b * SEQ; const int ch = n * 64 + lane;
        if (n != n_loaded) { n_loaded = n;
#pragma unroll
        for (int nn = 0; nn < 8; ++nn)
#pragma unroll
            for (int ks = 0; ks < 2; ++ks) { const float* src = (nn < 4 ? A_GWA : A_GWX) + (size_t)n * 4096 + (size_t)(32 * ks + 8 * fq) * 64 + 16 * (nn & 3) + c16;
                v4u pw; pw.x = pk2(src[0], src[64]); pw.y = pk2(src[128], src[192]); pw.z = pk2(src[256], src[320]); pw.w = pk2(src[384], src[448]); wf[nn][ks] = __builtin_bit_cast(bf16x8, pw); }
#pragma unroll
        for (int nn = 0; nn < 4; ++nn) { const int cg = n * 64 + 16 * nn + c16; bav[nn] = A_GBA[cg]; bxv[nn] = A_GBX[cg]; c8v[nn] = -8.0f * LOG2E * log1pf(expf(-A_LAM[cg])); }
        cb = A_CONVB[ch];
        cw0 = A_CONVW[ch]; cw1 = A_CONVW[DM + ch]; cw2 = A_CONVW[2 * DM + ch]; cw3 = A_CONVW[3 * DM + ch];
        }
        float hcar = sample ? A_STH[(size_t)b * DM + ch] : 0.f;
        const int ntile = (T + 127) / 128;
        const size_t rb = ((size_t)n * M + m0 + w * 16) * 64 + lane;
        const bf16* xp = W_XB + rb; const bf16* zp = W_ZB + rb; bf16* yp = W_MIX + rb;
        const bool act0 = w * 16 < T;
        float xv[16], zv[16], xm3 = 0.f, xm2 = 0.f, xm1 = 0.f;
#pragma unroll
        for (int tk = 0; tk < 16; ++tk) { xv[tk] = 0.f; zv[tk] = 0.f; }
        if (act0) {
#pragma unroll
            for (int tk = 0; tk < 16; ++tk) { xv[tk] = bf2f(xp[tk * 64]); zv[tk] = bf2f(zp[tk * 64]); }
            if (w > 0) { xm3 = bf2f(xp[-3 * 64]); xm2 = bf2f(xp[-2 * 64]); xm1 = bf2f(xp[-64]); }
            else if (sample) { xm3 = A_STCONV[(size_t)(b * 3 + 0) * DM + ch]; xm2 = A_STCONV[(size_t)(b * 3 + 1) * DM + ch]; xm1 = A_STCONV[(size_t)(b * 3 + 2) * DM + ch]; }
        }
        for (int tile = 0; tile < ntile; ++tile) {
            const int t0 = tile * 128 + w * 16; const bool act = t0 < T; const bool has_next = tile + 1 < ntile;
            float Aseg = 1.f, H = 0.f;
            if (act) {
#pragma unroll
                for (int tk = 0; tk < 16; ++tk) { xcs[tk * 64 + lane] = cb + cw0 * xm3 + cw1 * xm2 + cw2 * xm1 + cw3 * xv[tk]; xm3 = xm2; xm2 = xm1; xm1 = xv[tk]; }
                if (t0 + 16 == T) { float* cc = A->out + (sample ? O_CCS : O_CCP) + (size_t)(b * 3) * DM + ch; cc[0] = xm3; cc[DM] = xm2; cc[2 * DM] = xm1; }
                if (has_next) {
                    const bf16* xn = xp + (size_t)(tile + 1) * 128 * 64;
                    xm3 = bf2f(xn[-3 * 64]); xm2 = bf2f(xn[-2 * 64]); xm1 = bf2f(xn[-64]);
#pragma unroll
                    for (int tk = 0; tk < 16; ++tk) xv[tk] = bf2f(xn[tk * 64]);
                }
                LDS_WAIT(); asm volatile("" ::: "memory");
                bf16x8 af[2];
#pragma unroll
                for (int ks = 0; ks < 2; ++ks) { const LAS f32x4* xr = (const LAS f32x4*)(xcs + c16 * 64 + 32 * ks + 8 * fq); const f32x4 x0 = xr[0], x1 = xr[1];
                    v4u pw; pw.x = cvtpk_s(x0.x, x0.y); pw.y = cvtpk_s(x0.z, x0.w); pw.z = cvtpk_s(x1.x, x1.y); pw.w = cvtpk_s(x1.z, x1.w); af[ks] = __builtin_bit_cast(bf16x8, pw); }
                f32x4 acc[8];
#pragma unroll
                for (int nn = 0; nn < 8; ++nn) { const float bb = nn < 4 ? bav[nn & 3] : bxv[nn & 3]; acc[nn] = (f32x4){bb, bb, bb, bb};
                    acc[nn] = __builtin_amdgcn_mfma_f32_16x16x32_bf16(af[0], wf[nn][0], acc[nn], 0, 0, 0); acc[nn] = __builtin_amdgcn_mfma_f32_16x16x32_bf16(af[1], wf[nn][1], acc[nn], 0, 0, 0); }
#pragma unroll
                for (int nn = 0; nn < 4; ++nn)
#pragma unroll
                    for (int e = 0; e < 4; ++e) { const int o = (4 * fq + e) * 64 + 16 * nn + c16;
                        const float r = sigmoid_fast(acc[nn][e]), gi = sigmoid_fast(acc[nn + 4][e]); const float av = __builtin_amdgcn_exp2f(c8v[nn] * r);
                        as_[o] = av; us_[o] = __builtin_amdgcn_sqrtf(fmaxf(1.0f - av * av, 0.f)) * (gi * xcs[o]); }
                LDS_WAIT(); asm volatile("" ::: "memory");
#pragma unroll
                for (int tk = 0; tk < 16; ++tk) { const float av = as_[tk * 64 + lane]; H = av * H + us_[tk * 64 + lane]; Aseg *= av; }
            }
            LAS float* sg = segs + (tile & 1) * 1024;
            sg[w * 128 + lane] = Aseg; sg[w * 128 + 64 + lane] = H;
            LDS_WAIT(); __syncthreads();
            float hin = hcar, hall = hcar;
#pragma unroll
            for (int ww = 0; ww < 8; ++ww) { const float Aw = sg[ww * 128 + lane], Hw = sg[ww * 128 + 64 + lane]; hall = Aw * hall + Hw; if (ww < w) hin = Aw * hin + Hw; }
            hcar = hall;
            if (act) {
                float h = hin; bf16* yo = yp + (size_t)tile * 128 * 64;
#pragma unroll
                for (int tk = 0; tk < 16; ++tk) { h = as_[tk * 64 + lane] * h + us_[tk * 64 + lane]; yo[tk * 64] = (bf16)(cvtpk_s(h * zv[tk], 0.f) & 0xffffu); }
                if (has_next) { const bf16* zn = zp + (size_t)(tile + 1) * 128 * 64;
#pragma unroll
                    for (int tk = 0; tk < 16; ++tk) zv[tk] = bf2f(zn[tk * 64]); }
            }
        }
        if (w == 0) A->out[(sample ? O_CHS : O_CHP) + (size_t)b * DM + ch] = hcar;
        __syncthreads();
    }
}

template <int MODE>
__device__ __forceinline__ void mini_gemm_sample(Frame& F, const bf16* Ab, int a_ld, size_t a_kstep, const bf16* Bt, int N, bf16* O0, bf16* O1, const float* rs) {
    int lane = F.lane; asm volatile("" : "+v"(lane)); const int w = F.wave, fr = lane & 15, fq = lane >> 4;
    LAS float* part = (LAS float*)(F.lds + RING_OFF);
    const int ntn = N / 64;
    for (int jj = blockIdx.x / 8; jj < 2 * ntn; jj += F.G / 8) {
        const int tm = 2 * (blockIdx.x % 8) + jj / ntn, tn = jj % ntn; const int r0 = MP + 64 * tm, c0 = 64 * tn;
        f32x4 acc[4][4];
#pragma unroll
        for (int mi = 0; mi < 4; ++mi)
#pragma unroll
            for (int ni = 0; ni < 4; ++ni) acc[mi][ni] = (f32x4){0.f, 0.f, 0.f, 0.f};
#pragma unroll
        for (int kp = 0; kp < 2; ++kp) {
            const int k = 128 * w + 64 * kp + 8 * fq;
            const bf16* ap = Ab + (size_t)(k >> 6) * (a_kstep / 2) + (size_t)(r0 + fr) * a_ld + (k & 63);
            const bf16* bp = Bt + (size_t)(c0 + fr) * 1024 + k;
            bf16x8 af[2][4], bfm[2][4];
#pragma unroll
            for (int i = 0; i < 4; ++i) { af[0][i] = *(const GAS bf16x8*)(ap + (size_t)(16 * i) * a_ld); af[1][i] = *(const GAS bf16x8*)(ap + (size_t)(16 * i) * a_ld + 32);
                bfm[0][i] = *(const GAS bf16x8*)(bp + (size_t)(16 * i) * 1024); bfm[1][i] = *(const GAS bf16x8*)(bp + (size_t)(16 * i) * 1024 + 32); }
#pragma unroll
            for (int h2 = 0; h2 < 2; ++h2)
#pragma unroll
                for (int mi = 0; mi < 4; ++mi)
#pragma unroll
                    for (int ni = 0; ni < 4; ++ni) acc[mi][ni] = __builtin_amdgcn_mfma_f32_16x16x32_bf16(bfm[h2][ni], af[h2][mi], acc[mi][ni], 0, 0, 0);
        }
        __syncthreads();
#pragma unroll
        for (int mi = 0; mi < 4; ++mi)
#pragma unroll
            for (int ni = 0; ni < 4; ++ni) *(LAS f32x4*)(part + (size_t)w * 4096 + (16 * mi + fr) * 64 + (((4 * ni + fq) ^ (fr & 7)) << 2)) = acc[mi][ni];
        LDS_WAIT(); __syncthreads();
        const int rr = 8 * w + (lane >> 3), cc = 8 * (lane & 7);
        f32x4 s0 = (f32x4){0.f, 0.f, 0.f, 0.f}, s1 = s0;
#pragma unroll
        for (int pw = 0; pw < 8; ++pw) { const LAS float* pr = part + (size_t)pw * 4096 + rr * 64; const int c4 = cc >> 2;
            s0 = s0 + *(const LAS f32x4*)(pr + ((c4 ^ (rr & 7)) << 2)); s1 = s1 + *(const LAS f32x4*)(pr + (((c4 + 1) ^ (rr & 7)) << 2)); }
        const int row = r0 + rr;
        if (MODE == 0) { st_wt16((void*)(O0 + (size_t)row * 1024 + c0 + cc), __builtin_bit_cast(v4u, pg8::pack8(s0, s1))); }
        else { const bool isz = c0 >= 1024; if (isz) { s0 = pg8::silu4(s0); s1 = pg8::silu4(s1); }
            bf16* dst = (isz ? O1 : O0) + ((size_t)((c0 & 1023) >> 6) * M + row) * 64 + cc; st_wt16((void*)dst, __builtin_bit_cast(v4u, pg8::pack8(s0, s1))); }
    }
    __syncthreads();
}

#ifndef MK_N_LAUNCHES
#define MK_N_LAUNCHES 1
#endif
constexpr int PER_PHASE = 9;
constexpr int N_LAUNCHES = MK_N_LAUNCHES;
__global__ void __launch_bounds__(NWAVES * 64, 2) hybrid_fwd(Args A_) {
    extern __shared__ __attribute__((aligned(16))) unsigned char lds[];
    Frame F;
    F.lds = (LAS unsigned char*)lds;
    F.MISC = (volatile LAS unsigned*)(F.lds + MISC_OFF);
    F.tid = threadIdx.x; F.lane = F.tid & 63; F.wave = __builtin_amdgcn_readfirstlane(F.tid >> 6);
    F.G = gridDim.x; { const int bx = blockIdx.x; F.vcu = (F.G % 8 == 0) ? (bx % 8) * (F.G / 8) + bx / 8 : bx; }
    F.ctl = (gu32*)(A_.ws + WS_CTL);
    for (int u = F.tid; u < (LDS_BYTES - LDSCTL_OFF) / 4; u += NWAVES * 64) ((LAS unsigned*)(F.lds + LDSCTL_OFF))[u] = 0u;
    __syncthreads();
    XcdBarrier bar; bar.bar = (unsigned*)(F.ctl + CW_BAR); bar.x = 0; bar.st = nullptr;
    if (N_LAUNCHES == 1) bar = xcd_barrier_post((unsigned*)(F.ctl + CW_BAR), F.MISC + 8);
#define GRID_BAR() do { if (N_LAUNCHES == 1) xcd_barrier(bar); } while (0)
    const int lo = A_.ph_lo, hi = A_.ph_hi;
#ifndef PHMASK
#define PHMASK 0x1ff
#endif
#define IN(k) (((PHMASK >> (k)) & 1) && lo <= (k) && (k) < hi)
#define BOTH(k) (IN(k) && IN((k) + 1))
#ifndef PROBE_DUP
#define PROBE_DUP (-1)
#endif
#define REP(k) for (int rep_ = 0; rep_ < ((k) == PROBE_DUP ? 2 : 1); ++rep_)

    if (IN(0)) { CArgs A = kargs(); REP(0) p0_prologue(F, A); if (BOTH(0)) GRID_BAR(); }
    if (IN(1)) { CArgs A = kargs();
        pg8::Gemm g{W_XN, W_WIN0T, M, NIN, DM, DM, 128}; pg8::DynOrder S; S.init(M, NIN, F.G, (int)blockIdx.x); S.head = (unsigned*)(F.ctl + CW_GEMMQ); S.slot = (LAS unsigned*)(F.MISC + 16);
        pg8::EpiQKV E{A->ws + WS_R1, W_ROPE, A->out};
        REP(1) pg8::gemm_phase<pg8::EpiQKV, pg8::DynOrder, true, true>(F.lds + RING_OFF, g, S, E);
        cache_tail(F, A);
        if (BOTH(1)) GRID_BAR();
    }
    if (IN(2)) { CArgs A = kargs(); REP(2) attn_mfma_phase(F, A); if (BOTH(2)) GRID_BAR(); }
    if (IN(3)) { CArgs A = kargs();
        pg8::Gemm g{W_MIX, W_WOUT0T, MP, DM, DM, DM, 128}; pg8::StaticOrder S; S.init(MP, DM, F.G, (int)blockIdx.x);
        pg8::EpiBf16 E{W_M1, DM};
        REP(3) { pg8::gemm_phase<pg8::EpiBf16, pg8::StaticOrder, false, true>(F.lds + RING_OFF, g, S, E); mini_gemm_sample<0>(F, W_MIX, DM, 128, W_WOUT0T, DM, W_M1, nullptr, nullptr); }
        if (BOTH(3)) GRID_BAR();
    }
    if (IN(4)) { CArgs A = kargs(); REP(4) rowpass_phase<0>(F, A); if (BOTH(4)) GRID_BAR(); }
    if (IN(5)) { CArgs A = kargs();
        pg8::Gemm g{W_XN, W_WIN1T, MP, 2 * DM, DM, DM, 128}; pg8::StaticOrder S; S.init(MP, 2 * DM, F.G, (int)blockIdx.x);
        pg8::EpiXZ E{W_XB, W_ZB, W_RS2};
        REP(5) { pg8::gemm_phase<pg8::EpiXZ, pg8::StaticOrder, false, true>(F.lds + RING_OFF, g, S, E); mini_gemm_sample<1>(F, W_XN, DM, 128, W_WIN1T, 2 * DM, W_XB, W_ZB, W_RS2); }
        if (BOTH(5)) GRID_BAR();
    }
    if (IN(6)) { CArgs A = kargs(); REP(6) lru_phase(F, A); if (BOTH(6)) GRID_BAR(); }
    if (IN(7)) { CArgs A = kargs();
        pg8::Gemm g{W_MIX, W_WOUT1T, MP, DM, DM, 64, (size_t)M * 128}; pg8::StaticOrder S; S.init(MP, DM, F.G, (int)blockIdx.x);
        pg8::EpiBf16 E{W_M1, DM};
        REP(7) { pg8::gemm_phase<pg8::EpiBf16, pg8::StaticOrder, false, true>(F.lds + RING_OFF, g, S, E); mini_gemm_sample<0>(F, W_MIX, 64, (size_t)M * 128, W_WOUT1T, DM, W_M1, nullptr, nullptr); }
        if (BOTH(7)) GRID_BAR();
    }
    if (IN(8)) { CArgs A = kargs(); rowpass_phase<1>(F, A); }
#undef IN
#undef BOTH
}

extern "C" void kernel_launch(void* const* d_in, const int* in_sizes, int n_in, void* d_out, int out_size, void* d_ws, size_t ws_size, hipStream_t stream) {
    static int grid = 0;
    if (grid == 0) {
        if (n_in != 23 || in_sizes[0] != MP * DM || (size_t)out_size != O_END || ws_size < WS_END) { fprintf(stderr, "kernel_launch: unexpected shapes: n_in %d in0 %d out %d ws %zu\n", n_in, n_in > 0 ? in_sizes[0] : -1, out_size, ws_size); grid = -1; return; }
        int dev = 0, cus = 0, per_cu = 0;
        if (hipGetDevice(&dev) != hipSuccess || hipDeviceGetAttribute(&cus, hipDeviceAttributeMultiprocessorCount, dev) != hipSuccess) { grid = -1; return; }
        if (hipFuncSetAttribute((const void*)hybrid_fwd, hipFuncAttributeMaxDynamicSharedMemorySize, LDS_BYTES) != hipSuccess) { fprintf(stderr, "kernel_launch: hipFuncSetAttribute failed\n"); grid = -1; return; }
        if (hipOccupancyMaxActiveBlocksPerMultiprocessor(&per_cu, (const void*)hybrid_fwd, NWAVES * 64, LDS_BYTES) != hipSuccess || per_cu < 1) fprintf(stderr, "kernel_launch: occupancy query reports %d blocks per CU\n", per_cu);
        (void)hipGetLastError();
        grid = cus - cus % 8;
    }
    if (grid < 0) return;
    if (hipMemsetAsync((char*)d_ws + WS_CTL, 0, CTL_ZERO_BYTES, stream) != hipSuccess) { fprintf(stderr, "kernel_launch: memset failed\n"); return; }
    Args a{};
    for (int i = 0; i < 23; ++i) a.in[i] = (const float*)d_in[i];
    a.out = (float*)d_out; a.ws = (unsigned char*)d_ws;
    for (int li = 0; li < N_LAUNCHES; ++li) {
        a.ph_lo = (N_LAUNCHES == 1) ? 0 : li; a.ph_hi = (N_LAUNCHES == 1) ? PER_PHASE : li + 1;
        hipLaunchKernelGGL(hybrid_fwd, dim3(grid), dim3(NWAVES * 64), LDS_BYTES, stream, a);
        const hipError_t le = hipPeekAtLastError();
        if (le != hipSuccess) { fprintf(stderr, "kernel_launch: launch %d failed: %s\n", li, hipGetErrorName(le)); break; }
    }
}
```
